# Optimizing an MI355X kernel written in HIP

```python
import math
import jax, jax.numpy as jnp
from jax import lax
import numpy as np

D_MODEL = 1024
BATCH = 4
SEQ = 8192
DEPTH = 2
DEC_BATCH = 32
DEC_SEQ = 1
PAST_LEN = 16384
PAGE_SIZE = 128

N_A_LAYERS = DEPTH // 2
N_B_LAYERS = DEPTH - N_A_LAYERS
POOL_WINDOWS = (2, 4, 8, 16)
N_POOL_GROUPS = len(POOL_WINDOWS)
POOL_GROUP_DIM = D_MODEL // N_POOL_GROUPS
POOL_BUF = max(POOL_WINDOWS) - 1
D_FF = ((8 * D_MODEL // 3 + 255) // 256) * 256
HEAD_DIM = 128
N_HEADS = D_MODEL // HEAD_DIM
DILATED_GROUPS = ((128, 1), (512, 4), (2048, 16))
N_DIL = len(DILATED_GROUPS)
WINDOW_MAX = max(w for w, _ in DILATED_GROUPS)
ATTN_BLOCK = 128
ROT_DIM = HEAD_DIM // 4
ROPE_THETA = 500000.0
RMS_EPS = 1e-6

kernel_name = "yoco_pool_dilated_swa_step"


def rms_norm(x, g):
    xf = x.astype(jnp.float32)
    y = xf * lax.rsqrt(jnp.mean(xf * xf, axis=-1, keepdims=True) + RMS_EPS)
    return (y * g.astype(jnp.float32)).astype(x.dtype)


def swiglu(x, w_in, w_out):
    gu = x @ w_in
    g, u = jnp.split(gu, 2, axis=-1)
    return (jax.nn.silu(g) * u) @ w_out


def partial_rope(x, pos):
    half = ROT_DIM // 2
    inv_freq = ROPE_THETA ** (-jnp.arange(0, ROT_DIM, 2, dtype=jnp.float32) / ROT_DIM)
    ang = pos.astype(jnp.float32)[:, None] * inv_freq[None, :]
    cos = jnp.cos(ang)[:, None, :]
    sin = jnp.sin(ang)[:, None, :]
    xr = x[..., :ROT_DIM].astype(jnp.float32)
    x1, x2 = xr[..., :half], xr[..., half:]
    rot = jnp.concatenate([x1 * cos - x2 * sin, x2 * cos + x1 * sin], axis=-1)
    return jnp.concatenate([rot.astype(x.dtype), x[..., ROT_DIM:]], axis=-1)


def pool_mixer(u_ext, pos0, w_group, scale, w_o):
    B, n_ext, D = u_ext.shape
    T = n_ext - POOL_BUF
    cs = jnp.cumsum(u_ext.astype(jnp.float32), axis=1)
    cs = jnp.pad(cs, ((0, 0), (1, 0), (0, 0)))
    hi = cs[:, POOL_BUF + 1:]
    cur = u_ext[:, POOL_BUF:].astype(jnp.float32)
    pos = pos0 + jnp.arange(T, dtype=jnp.int32)
    parts = []
    for g, w in enumerate(POOL_WINDOWS):
        c = slice(g * POOL_GROUP_DIM, (g + 1) * POOL_GROUP_DIM)
        lo = lax.slice_in_dim(cs, POOL_BUF + 1 - w, POOL_BUF + 1 - w + T, axis=1)[..., c]
        cnt = jnp.minimum(pos + 1, w).astype(jnp.float32)[None, :, None]
        parts.append((hi[..., c] - lo) / cnt - cur[..., c])
    p = jnp.stack(parts, axis=2).astype(u_ext.dtype)
    z = jnp.einsum('btgc,gcd->btgd', p, w_group).reshape(B, T, D) * scale
    return z @ w_o


def dilated_attn_prompt(q, k, v, window, dil):
    B, S, H, E = q.shape
    sw = window // dil
    L = S // dil
    nb = -(-L // ATTN_BLOCK)
    Lp = nb * ATTN_BLOCK

    def to_sub(a):
        a = a.reshape(B, L, dil, H, E).transpose(0, 2, 1, 3, 4)
        a = jnp.pad(a, ((0, 0), (0, 0), (0, Lp - L), (0, 0), (0, 0)))
        return a.reshape(B, dil, nb, ATTN_BLOCK, H, E)

    def with_prev(a):
        prev = jnp.pad(a, ((0, 0), (0, 0), (1, 0), (0, 0), (0, 0), (0, 0)))[:, :, :nb]
        return jnp.concatenate([prev, a], axis=3)

    qb = to_sub(q)
    kc = with_prev(to_sub(k))
    vc = with_prev(to_sub(v))
    s = jnp.einsum('brnqhe,brnkhe->brnhqk', qb, kc,
                   preferred_element_type=jnp.float32) * (HEAD_DIM ** -0.5)
    blk = jnp.arange(nb)[:, None, None]
    qi = blk * ATTN_BLOCK + jnp.arange(ATTN_BLOCK)[None, :, None]
    kj = (blk - 1) * ATTN_BLOCK + jnp.arange(2 * ATTN_BLOCK)[None, None, :]
    diff = qi - kj
    valid = (diff >= 0) & (diff <= sw) & (kj >= 0)
    s = jnp.where(valid[None, None, :, None], s, -jnp.inf)
    m = jnp.max(s, axis=-1, keepdims=True)
    p = jnp.exp(s - m)
    den = jnp.sum(p, axis=-1, keepdims=True)
    o = jnp.einsum('brnhqk,brnkhe->brnqhe', (p / den).astype(v.dtype), vc)
    lse = (m + jnp.log(den))[..., 0]
    o = o.reshape(B, dil, Lp, H, E)[:, :, :L].transpose(0, 2, 1, 3, 4).reshape(B, S, H, E)
    lse = lse.transpose(0, 1, 2, 4, 3).reshape(B, dil, Lp, H)[:, :, :L]
    lse = lse.transpose(0, 2, 1, 3).reshape(B, S, H)
    return o, lse


def dilated_attn_sample(q, k_ext, v_ext, window, dil):
    B, T, H, E = q.shape
    n_past = k_ext.shape[1] - T
    sw = window // dil
    idx = n_past + jnp.arange(T)[:, None] - dil * jnp.arange(sw + 1)[None, :]
    valid = idx >= 0
    idx = jnp.maximum(idx, 0)
    kg = k_ext[:, idx]
    vg = v_ext[:, idx]
    s = jnp.einsum('bthe,btkhe->bthk', q, kg,
                   preferred_element_type=jnp.float32) * (HEAD_DIM ** -0.5)
    s = jnp.where(valid[None, :, None, :], s, -jnp.inf)
    m = jnp.max(s, axis=-1, keepdims=True)
    p = jnp.exp(s - m)
    den = jnp.sum(p, axis=-1, keepdims=True)
    o = jnp.einsum('bthk,btkhe->bthe', (p / den).astype(v_ext.dtype), vg)
    lse = (m + jnp.log(den))[..., 0]
    return o, lse


def combine_by_denominator(outs, lses):
    a = jax.nn.softmax(jnp.stack(lses, axis=0), axis=0)
    o = jnp.stack(outs, axis=0).astype(jnp.float32)
    return jnp.sum(a[..., None] * o, axis=0)


def trunk(x, pos0, pool_prev, k_past, v_past, p):
    B, T, D = x.shape
    pos = pos0 + jnp.arange(T, dtype=jnp.int32)
    pool_new = []
    k_all = v_all = k_state = v_state = None
    for l in range(DEPTH):
        if l == N_A_LAYERS:
            kv = rms_norm(x, p['kv_norm']) @ p['w_kv']
            k, v = jnp.split(kv, 2, axis=-1)
            k = partial_rope(k.reshape(B, T, N_HEADS, HEAD_DIM), pos)
            v = v.reshape(B, T, N_HEADS, HEAD_DIM)
            if k_past is None:
                k_all, v_all = k, v
                n_keep = min(WINDOW_MAX, T)
            else:
                k_all = jnp.concatenate([k_past.astype(k.dtype), k], axis=1)
                v_all = jnp.concatenate([v_past.astype(v.dtype), v], axis=1)
                n_keep = k_past.shape[1]
            k_state = k_all[:, k_all.shape[1] - n_keep:]
            v_state = v_all[:, v_all.shape[1] - n_keep:]
        x = x + 0.5 * swiglu(rms_norm(x, p['ffn1_norm'][l]), p['ffn1_w_in'][l], p['ffn1_w_out'][l])
        h = rms_norm(x, p['mix_norm'][l])
        if l < N_A_LAYERS:
            prev = jnp.zeros((B, POOL_BUF, D), h.dtype) if pool_prev is None else pool_prev[l].astype(h.dtype)
            u_ext = jnp.concatenate([prev, h], axis=1)
            pool_new.append(u_ext[:, -POOL_BUF:])
            x = x + pool_mixer(u_ext, pos0, p['pool_w_group'][l], p['pool_scale'][l], p['pool_w_o'][l])
        else:
            b = l - N_A_LAYERS
            q = (h @ p['attn_w_q'][b]).reshape(B, T, N_DIL * N_HEADS, HEAD_DIM)
            q = partial_rope(q, pos).reshape(B, T, N_DIL, N_HEADS, HEAD_DIM)
            outs, lses = [], []
            for g, (w, d) in enumerate(DILATED_GROUPS):
                if k_past is None:
                    o, s = dilated_attn_prompt(q[:, :, g], k_all, v_all, w, d)
                else:
                    o, s = dilated_attn_sample(q[:, :, g], k_all, v_all, w, d)
                outs.append(o)
                lses.append(s)
            att = combine_by_denominator(outs, lses).reshape(B, T, N_HEADS * HEAD_DIM).astype(x.dtype)
            x = x + att @ p['attn_w_o'][b]
        x = x + 0.5 * swiglu(rms_norm(x, p['ffn2_norm'][l]), p['ffn2_w_in'][l], p['ffn2_w_out'][l])
    y = rms_norm(x, p['final_norm'])
    return y, jnp.stack(pool_new, axis=0), k_state, v_state


def setup_inputs(seed: int = 0) -> dict:
    key = jax.random.key(seed)
    ks = jax.random.split(key, 24)
    f32 = jnp.float32

    def nrm(k, shape, scale):
        return jax.random.normal(k, shape, f32) * scale

    def gain(k, shape):
        return 1.0 + 0.02 * jax.random.normal(k, shape, f32)

    wb = min(WINDOW_MAX, PAST_LEN)
    qw = N_DIL * N_HEADS * HEAD_DIM
    hw = N_HEADS * HEAD_DIM
    return {
        'x_prompt': nrm(ks[0], (BATCH, SEQ, D_MODEL), 1.0),
        'x_sample': nrm(ks[1], (DEC_BATCH, DEC_SEQ, D_MODEL), 1.0),
        'state_pool': nrm(ks[2], (N_A_LAYERS, DEC_BATCH, POOL_BUF, D_MODEL), 1.0),
        'cache_k': nrm(ks[3], (DEC_BATCH, wb, N_HEADS, HEAD_DIM), 1.0),
        'cache_v': nrm(ks[4], (DEC_BATCH, wb, N_HEADS, HEAD_DIM), 1.0),
        'ffn1_norm': gain(ks[5], (DEPTH, D_MODEL)),
        'ffn1_w_in': nrm(ks[6], (DEPTH, D_MODEL, 2 * D_FF), D_MODEL ** -0.5),
        'ffn1_w_out': nrm(ks[7], (DEPTH, D_FF, D_MODEL), D_FF ** -0.5),
        'mix_norm': gain(ks[8], (DEPTH, D_MODEL)),
        'ffn2_norm': gain(ks[9], (DEPTH, D_MODEL)),
        'ffn2_w_in': nrm(ks[10], (DEPTH, D_MODEL, 2 * D_FF), D_MODEL ** -0.5),
        'ffn2_w_out': nrm(ks[11], (DEPTH, D_FF, D_MODEL), D_FF ** -0.5),
        'pool_w_group': nrm(ks[12], (N_A_LAYERS, N_POOL_GROUPS, POOL_GROUP_DIM, POOL_GROUP_DIM), POOL_GROUP_DIM ** -0.5),
        'pool_scale': gain(ks[13], (N_A_LAYERS, D_MODEL)),
        'pool_w_o': nrm(ks[14], (N_A_LAYERS, D_MODEL, D_MODEL), D_MODEL ** -0.5),
        'kv_norm': gain(ks[15], (D_MODEL,)),
        'w_kv': nrm(ks[16], (D_MODEL, 2 * hw), D_MODEL ** -0.5),
        'attn_w_q': nrm(ks[17], (N_B_LAYERS, D_MODEL, qw), D_MODEL ** -0.5),
        'attn_w_o': nrm(ks[18], (N_B_LAYERS, hw, D_MODEL), hw ** -0.5),
        'final_norm': gain(ks[19], (D_MODEL,)),
    }


def reference(x_prompt, x_sample, state_pool, cache_k, cache_v,
              ffn1_norm, ffn1_w_in, ffn1_w_out, mix_norm, ffn2_norm, ffn2_w_in, ffn2_w_out,
              pool_w_group, pool_scale, pool_w_o, kv_norm, w_kv, attn_w_q, attn_w_o, final_norm):
    params = {
        'ffn1_norm': ffn1_norm, 'ffn1_w_in': ffn1_w_in, 'ffn1_w_out': ffn1_w_out,
        'mix_norm': mix_norm,
        'ffn2_norm': ffn2_norm, 'ffn2_w_in': ffn2_w_in, 'ffn2_w_out': ffn2_w_out,
        'pool_w_group': pool_w_group, 'pool_scale': pool_scale, 'pool_w_o': pool_w_o,
        'kv_norm': kv_norm, 'w_kv': w_kv, 'attn_w_q': attn_w_q, 'attn_w_o': attn_w_o,
        'final_norm': final_norm,
    }
    past_len = PAST_LEN
    y_prompt, pool_p, k_p, v_p = trunk(x_prompt, 0, None, None, None, params)
    y_sample, pool_s, k_s, v_s = trunk(x_sample, past_len, state_pool, cache_k, cache_v, params)
    return (y_prompt, y_sample, pool_p, pool_s, k_p, v_p, k_s, v_s)
```

```cpp
#include <hip/hip_runtime.h>
#include <hip/hip_cooperative_groups.h>
#include <cstdio>
#include <cstdint>
namespace cg = cooperative_groups;

#define LAS __attribute__((address_space(3)))
#if defined(__HIP_DEVICE_COMPILE__)
#define GAS __attribute__((address_space(1)))
#else
#define GAS
#endif
typedef unsigned short bf16_t;
typedef short bf16x8 __attribute__((ext_vector_type(8)));
typedef short s16x4 __attribute__((ext_vector_type(4)));
typedef float f32x4 __attribute__((ext_vector_type(4)));
typedef float f32x2 __attribute__((ext_vector_type(2)));
typedef unsigned u32x4 __attribute__((ext_vector_type(4)));
typedef unsigned u32x2 __attribute__((ext_vector_type(2)));

constexpr int D = 1024, FF = 2816, NB = 4, SEQ = 8192, MP = NB * SEQ  , NS = 32  ;
constexpr int MT = MP + 256;
constexpr int MV = MP + NS;
constexpr int NH = 8, HD = 128, WMAX = 2048, PB = 15;
constexpr int NQ = 3 * D;
constexpr float RMS_EPS = 1e-6f;
constexpr float QSCALE = 0.08838834764831845f * 1.4426950408889634f;

constexpr size_t O_YP = 0, O_YS = (size_t)MP * D, O_SPP = O_YS + (size_t)NS * D, O_SPS = O_SPP + (size_t)NB * PB * D,
                 O_CKP = O_SPS + (size_t)NS * PB * D, O_CVP = O_CKP + (size_t)NB * WMAX * D, O_CKS = O_CVP + (size_t)NB * WMAX * D,
                 O_CVS = O_CKS + (size_t)NS * WMAX * D;

constexpr size_t MiB = 1u << 20;
constexpr size_t WS_WIN = 1 * MiB;
constexpr size_t WIN_BYTES = (size_t)2 * FF * D * 2;
constexpr size_t WS_WOUT = WS_WIN + 4 * WIN_BYTES;
constexpr size_t WOUT_BYTES = (size_t)D * FF * 2;
constexpr size_t WS_WPG = WS_WOUT + 4 * WOUT_BYTES;
constexpr size_t WS_WPO = WS_WPG + (size_t)D * 256 * 2;
constexpr size_t WS_WKV = WS_WPO + (size_t)D * D * 2;
constexpr size_t WS_WQ = WS_WKV + (size_t)2 * D * D * 2;
constexpr size_t WS_WO = WS_WQ + (size_t)NQ * D * 2;
constexpr size_t WS_ROPE = WS_WO + (size_t)D * D * 2;
constexpr size_t WS_SSQ = WS_ROPE + (size_t)8200 * 32 * 4;
constexpr size_t WS_LSE = WS_SSQ + (size_t)MT * 16 * 4;
constexpr size_t WS_XF = (WS_LSE + (size_t)3 * MT * 8 * 4 + 4095) & ~(size_t)4095;
constexpr size_t WS_XB = WS_XF + (size_t)MT * D * 4;
constexpr size_t WS_ACT = WS_XB + (size_t)MT * D * 2;
constexpr size_t WS_PB = WS_ACT + (size_t)MT * FF * 2;
constexpr size_t WS_ZB = WS_PB + (size_t)MT * D * 2;
constexpr size_t WS_KB = WS_ZB + (size_t)MT * D * 2;
constexpr size_t WS_VB = WS_KB + (size_t)MT * D * 2;
constexpr size_t WS_QB = WS_VB + (size_t)MT * D * 2;
constexpr size_t WS_OG = WS_QB + (size_t)MT * NQ * 2;
constexpr size_t WS_END = WS_OG + (size_t)3 * MT * D * 2;

constexpr int LDS_BYTES = 147456;

struct Params {
    const float* in[20];
    float* out;
    unsigned char* ws;
    double invf[16];
};

__device__ __forceinline__ unsigned cvt_pk_bf16(float lo, float hi) { unsigned r; asm volatile("v_cvt_pk_bf16_f32 %0, %1, %2" : "=v"(r) : "v"(lo), "v"(hi)); return r; }
__device__ __forceinline__ float bf2f(unsigned short b) { return __uint_as_float((unsigned)b << 16); }
__device__ __forceinline__ float wave_sum(float v) {
#pragma unroll
    for (int o = 1; o < 64; o <<= 1) v += __shfl_xor(v, o);
    return v;
}
__device__ __forceinline__ float wave_max(float v) {
#pragma unroll
    for (int o = 1; o < 64; o <<= 1) v = fmaxf(v, __shfl_xor(v, o));
    return v;
}

namespace pg8 {
constexpr int BM = 256, BK = 64, HALF = 128, HTB = HALF * BK * 2, STAGE_BYTES = 8 * HTB, NXCD = 8, WGM = 8;
__host__ __device__ __forceinline__ int lds_byte(int r, int c) { const int st = (r >> 4) * 2 + (c >> 5), rr = r & 15, cc = c & 31, ob = rr * 64 + cc * 2; return st * 1024 + (ob ^ (((ob >> 9) & 1) << 5)); }
__host__ __device__ __forceinline__ void stage_rc(int b, int& R, int& C) { const int st = b / 1024, sb = b % 1024, swz = sb ^ (((sb >> 9) & 1) << 5); R = (st >> 1) * 16 + swz / 64; C = (st & 1) * 32 + (swz % 64) / 2; }
__host__ __device__ __forceinline__ int perm32(int rho) { const int n = rho >> 4, i = rho & 15; return 8 * (i >> 2) + 4 * n + (i & 3); }

struct Unit { int pm, pn; };
struct Gemm { const GAS bf16_t* A; const GAS bf16_t* Bt; int M, N, K, lda, acol; };

struct StaticOrder {
    int nM, nN, nwg, G, c;
    __device__ void init(int M, int N, int G_, int c_) { nM = M / BM; nN = N / BM; nwg = nM * nN; G = G_; c = c_; }
    __device__ bool next(int i, Unit& u) const {
        const long L = (long)i * G + c; if (L >= nwg) return false;
        int wgid = (int)L; { const int q = nwg / NXCD, r = nwg % NXCD, xcd = wgid % NXCD, off = wgid / NXCD; wgid = (xcd < r ? xcd * (q + 1) : r * (q + 1) + (xcd - r) * q) + off; }
        const int nig = WGM * nN, gid = wgid / nig, fm = gid * WGM, gsz = (nM - fm) < WGM ? (nM - fm) : WGM;
        u.pm = fm + ((wgid % nig) % gsz); u.pn = (wgid % nig) / gsz; return true;
    }
};

template <class Epi>
__device__ __forceinline__ void gemm_phase(LAS unsigned char* lds, const Gemm g, const StaticOrder& S, const Epi& E) {
    const bool PERMR = E.perm();
    const int tid = threadIdx.x, wid = __builtin_amdgcn_readfirstlane(tid >> 6), lane = tid & 63, wr = wid >> 2, wc = wid & 3, fr = lane & 15, fq = lane >> 4;
    const int K = g.K, nt = K / BK;
    unsigned voffA[2], voffB[2];
#pragma unroll
    for (int i = 0; i < 2; ++i) { int R, C; stage_rc(tid * 16 + i * 8192, R, C); const int Rb = PERMR ? ((R & ~31) + perm32(R & 31)) : R;
        voffA[i] = (unsigned)(R * g.lda + C) * 2u; voffB[i] = (unsigned)(Rb * K + C) * 2u; }
    const size_t kstep = (size_t)(BK * 2);
    const size_t hstepA = (size_t)HALF * g.lda * 2, hstepB = (size_t)HALF * K * 2;
    const unsigned ldsw = (unsigned)wid * 1024u;
    const int aoff = lds_byte(wr * 64 + fr, fq * 8), boff = lds_byte(wc * 32 + fr, fq * 8);
#define PG8_SA(b, h) (((b) * 2 + (h)) * HTB)
#define PG8_SB(b, h) ((4 + (b) * 2 + (h)) * HTB)
#define PG8_STAGE(bufoff, gbase, voff) do { _Pragma("unroll") for (int _i = 0; _i < 2; ++_i) \
        __builtin_amdgcn_global_load_lds((const unsigned*)((const char*)(gbase) + (voff)[_i]), (LAS unsigned*)(lds + (bufoff) + ldsw + _i * 8192), 16, 0, 0); } while (0)
#define PG8_LDA(dst, b, h) do { _Pragma("unroll") for (int m = 0; m < 4; ++m) _Pragma("unroll") for (int k = 0; k < 2; ++k) dst[m][k] = *(const LAS bf16x8*)(lds + PG8_SA(b, h) + aoff + m * 2048 + k * 1024); } while (0)
#define PG8_LDB(dst, b, h) do { _Pragma("unroll") for (int n = 0; n < 2; ++n) _Pragma("unroll") for (int k = 0; k < 2; ++k) dst[n][k] = *(const LAS bf16x8*)(lds + PG8_SB(b, h) + boff + n * 2048 + k * 1024); } while (0)
#define PG8_MMA(ai, bj, At, Bt) do { __builtin_amdgcn_s_setprio(1); _Pragma("unroll") for (int m = 0; m < 4; ++m) _Pragma("unroll") for (int n = 0; n < 2; ++n) _Pragma("unroll") for (int k = 0; k < 2; ++k) \
        acc[ai][bj][m][n] = __builtin_amdgcn_mfma_f32_16x16x32_bf16(Bt[n][k], At[m][k], acc[ai][bj][m][n], 0, 0, 0); __builtin_amdgcn_s_setprio(0); } while (0)
#define PG8_WAIT_V(n) asm volatile("s_waitcnt vmcnt(" #n ")" ::: "memory")
#define PG8_WAIT_L(n) asm volatile("s_waitcnt lgkmcnt(" #n ")" ::: "memory")
#define PG8_BAR __builtin_amdgcn_s_barrier()
#define PG8_SCHED __builtin_amdgcn_sched_barrier(0)
    Unit cur, nxt; int ui = 0;
    if (!S.next(0, cur)) return;
    f32x4 acc[2][2][4][2];
#pragma unroll
    for (int a = 0; a < 2; ++a)
#pragma unroll
        for (int b = 0; b < 2; ++b)
#pragma unroll
            for (int m = 0; m < 4; ++m)
#pragma unroll
                for (int n = 0; n < 2; ++n) acc[a][b][m][n] = (f32x4){0.f, 0.f, 0.f, 0.f};
    bf16x8 At[4][2], B0[2][2], B1[2][2];
    const char* cA = (const char*)g.A + (size_t)cur.pm * 2 * hstepA + (size_t)cur.pn * g.acol * 2;
    const char* cB = (const char*)g.Bt + (size_t)cur.pn * 2 * hstepB;
    PG8_STAGE(PG8_SB(0, 0), cB, voffB); PG8_STAGE(PG8_SB(0, 1), cB + hstepB, voffB); PG8_STAGE(PG8_SA(0, 0), cA, voffA); PG8_STAGE(PG8_SA(0, 1), cA + hstepA, voffA);
    if (wr == 1) PG8_BAR;
    PG8_WAIT_V(2); PG8_BAR;
    PG8_STAGE(PG8_SB(1, 0), cB + kstep, voffB); PG8_STAGE(PG8_SA(1, 0), cA + kstep, voffA); PG8_STAGE(PG8_SB(1, 1), cB + hstepB + kstep, voffB);
    PG8_WAIT_V(6); PG8_BAR;
    for (;;) {
        const bool has_next = S.next(ui + 1, nxt);
        const char* nA = has_next ? (const char*)g.A + (size_t)nxt.pm * 2 * hstepA + (size_t)nxt.pn * g.acol * 2 : cA;
        const char* nB = has_next ? (const char*)g.Bt + (size_t)nxt.pn * 2 * hstepB : cB;
        for (int t = 0; t < nt; t += 2) {
            const bool last = (t == nt - 2);
            const char* a1 = cA + (size_t)(t + 1) * kstep;
            const char* a2 = last ? nA : cA + (size_t)(t + 2) * kstep; const char* b2 = last ? nB : cB + (size_t)(t + 2) * kstep;
            const char* a3 = a2 + kstep; const char* b3 = b2 + kstep;
            PG8_LDB(B0, 0, 0); PG8_LDB(B1, 0, 1); PG8_SCHED; PG8_LDA(At, 0, 0); PG8_STAGE(PG8_SA(1, 1), a1 + hstepA, voffA);
            PG8_WAIT_V(8); PG8_WAIT_L(0); PG8_BAR; PG8_MMA(0, 0, At, B0); PG8_MMA(0, 1, At, B1); PG8_BAR; PG8_SCHED;
            PG8_LDA(At, 0, 1); PG8_STAGE(PG8_SB(0, 0), b2, voffB); PG8_STAGE(PG8_SB(0, 1), b2 + hstepB, voffB); PG8_STAGE(PG8_SA(0, 0), a2, voffA);
            PG8_WAIT_V(8); PG8_WAIT_L(0); PG8_BAR; PG8_MMA(1, 0, At, B0); PG8_MMA(1, 1, At, B1); PG8_BAR; PG8_SCHED;
            PG8_LDB(B0, 1, 0); PG8_LDB(B1, 1, 1); PG8_SCHED; PG8_LDA(At, 1, 0); PG8_STAGE(PG8_SA(0, 1), a2 + hstepA, voffA);
            PG8_WAIT_V(8); PG8_WAIT_L(0); PG8_BAR; PG8_MMA(0, 0, At, B0); PG8_MMA(0, 1, At, B1); PG8_BAR; PG8_SCHED;
            PG8_LDA(At, 1, 1); PG8_STAGE(PG8_SB(1, 0), b3, voffB); PG8_STAGE(PG8_SB(1, 1), b3 + hstepB, voffB); PG8_STAGE(PG8_SA(1, 0), a3, voffA);
            PG8_WAIT_V(8); PG8_WAIT_L(0); PG8_BAR; PG8_MMA(1, 0, At, B0); PG8_MMA(1, 1, At, B1); PG8_BAR; PG8_SCHED;
        }
        if (wr == 0) PG8_BAR;
        E(acc, cur, wr, wc, fr, fq);
        if (!has_next) break;
#pragma unroll
        for (int a = 0; a < 2; ++a)
#pragma unroll
            for (int b = 0; b < 2; ++b)
#pragma unroll
                for (int m = 0; m < 4; ++m)
#pragma unroll
                    for (int n = 0; n < 2; ++n) acc[a][b][m][n] = (f32x4){0.f, 0.f, 0.f, 0.f};
        cur = nxt; cA = nA; cB = nB; ++ui;
        if (wr == 1) PG8_BAR;
    }
    PG8_WAIT_V(0);
    PG8_BAR;
#undef PG8_SA
#undef PG8_SB
#undef PG8_STAGE
#undef PG8_LDA
#undef PG8_LDB
#undef PG8_MMA
#undef PG8_WAIT_V
#undef PG8_WAIT_L
#undef PG8_BAR
#undef PG8_SCHED
}
}
using pg8::Unit;

__device__ __forceinline__ float row_rs(const GAS float* ssq, int row, int fq) {
    const f32x4 v = *(const GAS f32x4*)(ssq + (size_t)row * 16 + fq * 4);
    float s = (v[0] + v[1]) + (v[2] + v[3]);
    s += __shfl_xor(s, 16); s += __shfl_xor(s, 32);
    return rsqrtf(s * (1.0f / D) + RMS_EPS);
}
__device__ __forceinline__ float silu_mul(float g, float u) { const float e = __builtin_amdgcn_exp2f(-g * 1.4426950408889634f); return g * __builtin_amdgcn_rcpf(1.0f + e) * u; }

struct EpiAll {
    int kind;
    GAS void* p0; GAS void* p1; GAS float* ssq; const GAS float* rope; GAS float* out; float alpha;
    __device__ __forceinline__ bool perm() const { return kind < 3 || kind == 5; }
    template <int NAI, int NM>
    __device__ __forceinline__ void swiglu(const f32x4 (&acc)[2][2][4][2], const Unit& u, int wr, int wc, int fr, int fq) const {
        GAS bf16_t* O = (GAS bf16_t*)p0;
        const int row0 = u.pm * 256 + wr * 64 + fr, col0 = u.pn * 128 + wc * 32 + 8 * fq;
#pragma unroll
        for (int ai = 0; ai < NAI; ++ai)
#pragma unroll
            for (int m = 0; m < NM; ++m) {
                const int row = row0 + ai * 128 + m * 16; const float r = row_rs(ssq, row, fq);
                const float r2 = r * r, cneg = r * -1.4426950408889634f;
                float o[8];
#pragma unroll
                for (int n = 0; n < 2; ++n)
#pragma unroll
                    for (int e = 0; e < 4; ++e) { const float g = acc[ai][0][m][n][e], uu = acc[ai][1][m][n][e];
                        o[n * 4 + e] = (g * uu) * r2 * __builtin_amdgcn_rcpf(1.0f + __builtin_amdgcn_exp2f(g * cneg)); }
                u32x4 w; w.x = cvt_pk_bf16(o[0], o[1]); w.y = cvt_pk_bf16(o[2], o[3]); w.z = cvt_pk_bf16(o[4], o[5]); w.w = cvt_pk_bf16(o[6], o[7]);
                *(GAS u32x4*)(O + (size_t)row * FF + col0) = w;
            }
    }
    template <bool FINAL, int NAI, int NM>
    __device__ __forceinline__ void res(const f32x4 (&acc)[2][2][4][2], const Unit& u, int wr, int wc, int fr, int fq) const {
        GAS float* X = (GAS float*)p0; GAS bf16_t* XB = (GAS bf16_t*)p1;
        const int row0 = u.pm * 256 + wr * 64 + fr, col0 = u.pn * 256 + wc * 32 + 8 * fq;
#pragma unroll
        for (int ai = 0; ai < NAI; ++ai)
#pragma unroll
            for (int m = 0; m < NM; ++m) {
                const int row = row0 + ai * 128 + m * 16; float ss = 0.f;
#pragma unroll
                for (int bj = 0; bj < 2; ++bj) {
                    GAS bf16_t* px = XB + (size_t)row * D + col0 + bj * 128;
                    const u32x4 ob = *(const GAS u32x4*)px;
                    const f32x4 b0 = (f32x4){__uint_as_float(ob.x << 16), __uint_as_float(ob.x & 0xffff0000u), __uint_as_float(ob.y << 16), __uint_as_float(ob.y & 0xffff0000u)};
                    const f32x4 b1 = (f32x4){__uint_as_float(ob.z << 16), __uint_as_float(ob.z & 0xffff0000u), __uint_as_float(ob.w << 16), __uint_as_float(ob.w & 0xffff0000u)};
                    const f32x4 v0 = b0 + acc[ai][bj][m][0] * alpha, v1 = b1 + acc[ai][bj][m][1] * alpha;
                    ss += (v0[0] * v0[0] + v0[1] * v0[1]) + (v0[2] * v0[2] + v0[3] * v0[3]) + (v1[0] * v1[0] + v1[1] * v1[1]) + (v1[2] * v1[2] + v1[3] * v1[3]);
                    if (FINAL) { GAS float* pf = X + (size_t)row * D + col0 + bj * 128; *(GAS f32x4*)pf = v0; *(GAS f32x4*)(pf + 4) = v1; }
                    else { u32x4 w; w.x = cvt_pk_bf16(v0[0], v0[1]); w.y = cvt_pk_bf16(v0[2], v0[3]); w.z = cvt_pk_bf16(v1[0], v1[1]); w.w = cvt_pk_bf16(v1[2], v1[3]); *(GAS u32x4*)px = w; }
                }
                ss += __shfl_xor(ss, 16); ss += __shfl_xor(ss, 32);
                if (fq == 0) ssq[(size_t)row * 16 + u.pn * 4 + wc] = ss;
            }
    }
    template <int NAI, int NM>
    __device__ __forceinline__ void store(const f32x4 (&acc)[2][2][4][2], const Unit& u, int wr, int wc, int fr, int fq) const {
        GAS bf16_t* O = (GAS bf16_t*)p0;
        const int row0 = u.pm * 256 + wr * 64 + fr, col0 = u.pn * 256 + wc * 32 + 8 * fq;
#pragma unroll
        for (int ai = 0; ai < NAI; ++ai)
#pragma unroll
            for (int m = 0; m < NM; ++m) {
                const int row = row0 + ai * 128 + m * 16;
#pragma unroll
                for (int bj = 0; bj < 2; ++bj) {
                    const f32x4 v0 = acc[ai][bj][m][0], v1 = acc[ai][bj][m][1];
                    u32x4 w; w.x = cvt_pk_bf16(v0[0], v0[1]); w.y = cvt_pk_bf16(v0[2], v0[3]); w.z = cvt_pk_bf16(v1[0], v1[1]); w.w = cvt_pk_bf16(v1[2], v1[3]);
                    *(GAS u32x4*)(O + (size_t)row * D + col0 + bj * 128) = w;
                }
            }
    }
    template <bool ISQ, int NAI, int NM>
    __device__ __forceinline__ void kvq(const f32x4 (&acc)[2][2][4][2], const Unit& u, int wr, int wc, int fr, int fq) const {
        const int row0 = u.pm * 256 + wr * 64 + fr;
        const bool isK = ISQ || u.pn < 4;
        const int colb = (ISQ ? u.pn : (u.pn & 3)) * 256 + wc * 32 + 4 * fq;
        GAS bf16_t* dstb = (GAS bf16_t*)((ISQ || isK) ? p0 : p1);
        const int ldo = ISQ ? NQ : D;
        const bool dorope = isK && wc == 0;
#pragma unroll
        for (int ai = 0; ai < NAI; ++ai)
#pragma unroll
            for (int m = 0; m < NM; ++m) {
                const int row = row0 + ai * 128 + m * 16; const float r = row_rs(ssq, row, fq) * (ISQ ? QSCALE : 1.0f);
                const bool prompt = row < MP;
                const int t = row & (SEQ - 1), b = row >> 13, sb = row - MP;
                const int pidx = prompt ? t : SEQ;
                GAS float* fdst = nullptr;
                if (!ISQ) {
                    if (prompt) { if (t >= SEQ - WMAX) fdst = out + (isK ? O_CKP : O_CVP) + ((size_t)b * WMAX + (t - (SEQ - WMAX))) * D; }
                    else if (sb < NS) fdst = out + (isK ? O_CKS : O_CVS) + ((size_t)sb * WMAX + (WMAX - 1)) * D;
                }
                f32x4 cs = (f32x4){1.f, 1.f, 1.f, 1.f}, sn = (f32x4){0.f, 0.f, 0.f, 0.f};
                if (dorope) { cs = *(const GAS f32x4*)(rope + (size_t)pidx * 32 + 4 * fq); sn = *(const GAS f32x4*)(rope + (size_t)pidx * 32 + 16 + 4 * fq); }
#pragma unroll
                for (int bj = 0; bj < 2; ++bj) {
                    f32x4 v0 = acc[ai][bj][m][0] * r, v1 = acc[ai][bj][m][1] * r;
                    if (dorope) { const f32x4 r1 = v0 * cs - v1 * sn, r2 = v1 * cs + v0 * sn; v0 = r1; v1 = r2; }
                    const int c = colb + bj * 128;
                    u32x2 w0, w1; w0.x = cvt_pk_bf16(v0[0], v0[1]); w0.y = cvt_pk_bf16(v0[2], v0[3]); w1.x = cvt_pk_bf16(v1[0], v1[1]); w1.y = cvt_pk_bf16(v1[2], v1[3]);
                    *(GAS u32x2*)(dstb + (size_t)row * ldo + c) = w0; *(GAS u32x2*)(dstb + (size_t)row * ldo + c + 16) = w1;
                    if (!ISQ) { if (fdst) { *(GAS f32x4*)(fdst + c) = v0; *(GAS f32x4*)(fdst + c + 16) = v1; } }
                }
            }
    }
    template <int NAI, int NM>
    __device__ __forceinline__ void run(const f32x4 (&acc)[2][2][4][2], const Unit& u, int wr, int wc, int fr, int fq) const {
        if (kind == 0) swiglu<NAI, NM>(acc, u, wr, wc, fr, fq);
        else if (kind == 1) res<false, NAI, NM>(acc, u, wr, wc, fr, fq);
        else if (kind == 5) res<true, NAI, NM>(acc, u, wr, wc, fr, fq);
        else if (kind == 2) store<NAI, NM>(acc, u, wr, wc, fr, fq);
        else if (kind == 3) kvq<false, NAI, NM>(acc, u, wr, wc, fr, fq);
        else kvq<true, NAI, NM>(acc, u, wr, wc, fr, fq);
    }
    __device__ __forceinline__ void operator()(const f32x4 (&acc)[2][2][4][2], const Unit& u, int wr, int wc, int fr, int fq) const { run<2, 4>(acc, u, wr, wc, fr, fq); }
};

__device__ __forceinline__ void skinny_item(LAS unsigned char* lds, const pg8::Gemm g, const EpiAll& E, int item) {
    int t_ = threadIdx.x; asm volatile("" : "+v"(t_));
    const int tid = t_, lane = tid & 63, wave = __builtin_amdgcn_readfirstlane(tid >> 6), fr = lane & 15, fq = lane >> 4;
    const int pn = item >> 2, wc = item & 3, K = g.K, ksp = K >> 3, steps = ksp >> 5;
    const bool perm = E.perm();
    const GAS bf16_t* ap[2]; const GAS bf16_t* bp[2][2];
#pragma unroll
    for (int m = 0; m < 2; ++m) ap[m] = g.A + (size_t)(MP + 16 * m + fr) * g.lda + (size_t)pn * g.acol + wave * ksp + 8 * fq;
#pragma unroll
    for (int bj = 0; bj < 2; ++bj)
#pragma unroll
        for (int n = 0; n < 2; ++n) { const int rloc = perm ? (8 * (fr >> 2) + 4 * n + (fr & 3)) : (16 * n + fr);
            bp[bj][n] = g.Bt + (size_t)(256 * pn + 128 * bj + 32 * wc + rloc) * K + wave * ksp + 8 * fq; }
    f32x4 acc[2][2][4][2];
#pragma unroll
    for (int bj = 0; bj < 2; ++bj)
#pragma unroll
        for (int m = 0; m < 2; ++m)
#pragma unroll
            for (int n = 0; n < 2; ++n) acc[0][bj][m][n] = (f32x4){0.f, 0.f, 0.f, 0.f};
    for (int s0 = 0; s0 < steps; s0 += 6) {
        bf16x8 a[6][2], b[6][2][2];
#pragma unroll
        for (int t = 0; t < 6; ++t) { const int s = (s0 + t < steps) ? s0 + t : steps - 1;
#pragma unroll
            for (int m = 0; m < 2; ++m) a[t][m] = *(const GAS bf16x8*)(ap[m] + 32 * s);
#pragma unroll
            for (int bj = 0; bj < 2; ++bj)
#pragma unroll
                for (int n = 0; n < 2; ++n) b[t][bj][n] = *(const GAS bf16x8*)(bp[bj][n] + 32 * s); }
#pragma unroll
        for (int t = 0; t < 6; ++t) if (s0 + t < steps) {
#pragma unroll
            for (int bj = 0; bj < 2; ++bj)
#pragma unroll
                for (int m = 0; m < 2; ++m)
#pragma unroll
                    for (int n = 0; n < 2; ++n) acc[0][bj][m][n] = __builtin_amdgcn_mfma_f32_16x16x32_bf16(b[t][bj][n], a[t][m], acc[0][bj][m][n], 0, 0, 0);
        }
    }
    LAS f32x4* red = (LAS f32x4*)lds;
#pragma unroll
    for (int bj = 0; bj < 2; ++bj)
#pragma unroll
        for (int m = 0; m < 2; ++m)
#pragma unroll
            for (int n = 0; n < 2; ++n) red[(wave * 8 + (bj * 4 + m * 2 + n)) * 64 + lane] = acc[0][bj][m][n];
    __syncthreads();
    if (wave == 0) {
#pragma unroll
        for (int bj = 0; bj < 2; ++bj)
#pragma unroll
            for (int m = 0; m < 2; ++m)
#pragma unroll
                for (int n = 0; n < 2; ++n) { f32x4 s = red[(bj * 4 + m * 2 + n) * 64 + lane];
#pragma unroll
                    for (int w = 1; w < 8; ++w) s += red[(w * 8 + (bj * 4 + m * 2 + n)) * 64 + lane];
                    acc[0][bj][m][n] = s; }
        Unit u; u.pm = MP / 256; u.pn = pn;
        E.run<1, 2>(acc, u, 0, wc, fr, fq);
    }
    __syncthreads();
}
__device__ __forceinline__ void transpose_item(const float* W, int K, int N, bf16_t* WT, int dst_row0, int k0, int n0, LAS float* scr, int lane, const float* kgain, const float* ngain) {
    { f32x4 v[8];
#pragma unroll
      for (int i = 0; i < 8; ++i) { const int kk = 8 * i + (lane >> 3); v[i] = *(const GAS f32x4*)(W + (size_t)(k0 + kk) * N + n0 + 4 * (lane & 7)); }
#pragma unroll
      for (int i = 0; i < 8; ++i) { const int kk = 8 * i + (lane >> 3); const float kg = kgain ? kgain[k0 + kk] : 1.0f; LAS float* d = scr + kk * 33 + 4 * (lane & 7);
          d[0] = v[i][0] * kg; d[1] = v[i][1] * kg; d[2] = v[i][2] * kg; d[3] = v[i][3] * kg; } }
    asm volatile("s_waitcnt lgkmcnt(0)" ::: "memory");
    const int c = lane & 7;
#pragma unroll
    for (int j = 0; j < 4; ++j) { const int n = (lane >> 3) + 8 * j; const LAS float* s = scr + (8 * c) * 33 + n; const float ng = ngain ? ngain[n0 + n] : 1.0f;
        u32x4 o; o.x = cvt_pk_bf16(s[0 * 33] * ng, s[1 * 33] * ng); o.y = cvt_pk_bf16(s[2 * 33] * ng, s[3 * 33] * ng); o.z = cvt_pk_bf16(s[4 * 33] * ng, s[5 * 33] * ng); o.w = cvt_pk_bf16(s[6 * 33] * ng, s[7 * 33] * ng);
        *(GAS u32x4*)(WT + (size_t)(dst_row0 + n) * K + k0 + 8 * c) = o; }
    asm volatile("s_waitcnt lgkmcnt(0)" ::: "memory");
}
__device__ __forceinline__ void transpose_matrix(const float* W, int K, int N, bf16_t* WT, int mode, const float* kgain, const float* ngain, LAS float* scr, int gw, int NGW, int lane) {
    const int nblk = N / 32, items = (K / 64) * nblk;
    for (int it = gw; it < items; it += NGW) {
        const int kb = it / nblk, nb = it % nblk, k0 = 64 * kb, n0 = 32 * nb;
        int dr = n0;
        if (mode == 1) { if (n0 < FF) dr = 256 * (n0 / 128) + (n0 % 128); else { const int f = n0 - FF; dr = 256 * (f / 128) + 128 + (f % 128); } }
        transpose_item(W, K, N, WT, dr, k0, n0, scr, lane, kgain, ngain);
    }
}
__device__ __forceinline__ void sincos_d(double x, double& s, double& c) {
    const double kq = rint(x * 0.63661977236758134308);
    double r = fma(-kq, 1.57079632679489655800e+00, x); r = fma(-kq, 6.12323399573676603587e-17, r);
    const double r2 = r * r;
    const double sp = r * (1.0 + r2 * (-1.0 / 6 + r2 * (1.0 / 120 + r2 * (-1.0 / 5040 + r2 * (1.0 / 362880 + r2 * (-1.0 / 39916800 + r2 * (1.0 / 6227020800.0 + r2 * (-1.0 / 1307674368000.0))))))));
    const double cp = 1.0 + r2 * (-0.5 + r2 * (1.0 / 24 + r2 * (-1.0 / 720 + r2 * (1.0 / 40320 + r2 * (-1.0 / 3628800 + r2 * (1.0 / 479001600.0 + r2 * (-1.0 / 87178291200.0 + r2 * (1.0 / 20922789888000.0))))))));
    const int q = (int)((long long)kq & 3);
    s = (q == 0) ? sp : (q == 1) ? cp : (q == 2) ? -sp : -cp;
    c = (q == 0) ? cp : (q == 1) ? -sp : (q == 2) ? -cp : sp;
}

__device__ __forceinline__ int kv_off(int row, int ch) { return 256 * row + 16 * (ch ^ (((row & 3) << 2) | ((row >> 2) & 3))); }

#define XB_TMO      128
#define XB_XCNT(j)  (256  + 64 * (j))
#define XB_XSUB(j)  (1280 + 64 * (j))
#define XB_XGEN(j)  (2304 + 64 * (j))
#define XB_TOP      3328
#define XB_TOPGEN   3392
#define XCD_BAR_WORDS 3456
#define XB_SPIN_CAP (1u << 18)

__device__ __forceinline__ unsigned xb_ld(unsigned* p)              { return __hip_atomic_load(p, __ATOMIC_RELAXED, __HIP_MEMORY_SCOPE_AGENT); }
__device__ __forceinline__ unsigned xb_add(unsigned* p, unsigned v) { return __hip_atomic_fetch_add(p, v, __ATOMIC_RELAXED, __HIP_MEMORY_SCOPE_AGENT); }
__device__ __forceinline__ unsigned xb_xcc_id() { return (unsigned)__builtin_amdgcn_s_getreg((3 << 11) | 20) & 0xFu; }
#define XB_SPIN(cond, bar) do { unsigned _sp = 0; while (cond) { __builtin_amdgcn_s_sleep(1); \
    if ((++_sp & 255u) == 0u) { if (xb_ld(&(bar)[XB_TMO])) break; if (_sp > XB_SPIN_CAP) { atomicAdd(&(bar)[XB_TMO], 1u); break; } } } } while (0)

struct XcdBarrier {
    unsigned* bar; unsigned x;
    volatile LAS unsigned* st;
};

__device__ __forceinline__ XcdBarrier xcd_barrier_post(unsigned* bar, volatile LAS unsigned* st) {
    XcdBarrier b; b.bar = bar; b.x = xb_xcc_id(); b.st = st;
    if (threadIdx.x == 0) (void)xb_add(&bar[XB_XCNT(b.x)], 1u);
    return b;
}
__device__ __forceinline__ void xcd_barrier_complete(unsigned* bar, unsigned x, unsigned& nloc, unsigned& nx) {
    const unsigned G = gridDim.x * gridDim.y * gridDim.z;
    unsigned sum, cnt, mine, sp = 0u;
    for (;;) {
        sum = 0u; cnt = 0u; mine = 0u;
#pragma unroll
        for (unsigned j = 0; j < 16; ++j) { const unsigned c = xb_ld(&bar[XB_XCNT(j)]); sum += c; cnt += (c > 0u) ? 1u : 0u; mine = (j == x) ? c : mine; }
        if (sum == G) break;
        __builtin_amdgcn_s_sleep(1);
        if ((++sp & 255u) == 0u) { if (xb_ld(&bar[XB_TMO])) break; if (sp > XB_SPIN_CAP) { atomicAdd(&bar[XB_TMO], 1u); break; } }
    }
    nloc = mine > 0u ? mine : 1u; nx = cnt > 0u ? cnt : 1u;
}

__device__ __forceinline__ void xcd_barrier(const XcdBarrier& b) {
    asm volatile("s_waitcnt vmcnt(0)" ::: "memory");
    __syncthreads();
    if (threadIdx.x == 0) {
        unsigned* bar = b.bar;
        __builtin_amdgcn_s_waitcnt(0);
        unsigned nloc = b.st[0], nx = b.st[1];
        if (nloc == 0u) { xcd_barrier_complete(bar, b.x, nloc, nx); b.st[0] = nloc; b.st[1] = nx; }
        const unsigned old = xb_add(&bar[XB_XSUB(b.x)], 1u);
        const unsigned gen = old / nloc;
        if (old + 1u == (gen + 1u) * nloc) {
            __builtin_amdgcn_fence(__ATOMIC_RELEASE, "agent");
            asm volatile("s_waitcnt vmcnt(0)" ::: "memory");
            const unsigned og = xb_add(&bar[XB_TOP], 1u);
            const unsigned tg = og / nx;
            if (og + 1u == (tg + 1u) * nx) xb_add(&bar[XB_TOPGEN], 1u);
            else XB_SPIN(xb_ld(&bar[XB_TOPGEN]) == tg, bar);
            __builtin_amdgcn_fence(__ATOMIC_ACQUIRE, "agent");
            xb_add(&bar[XB_XGEN(b.x)], 1u);
            asm volatile("s_waitcnt vmcnt(0)" ::: "memory");
        } else {
            XB_SPIN(xb_ld(&bar[XB_XGEN(b.x)]) == gen, bar);
            __builtin_amdgcn_fence(__ATOMIC_ACQUIRE, "agent");
            asm volatile("s_waitcnt vmcnt(0)" ::: "memory");
        }
    }
    __syncthreads();
}

constexpr int TAB_OFF = 131072;
struct GD { unsigned long long A, Bt, p0, p1; int N, K, lda, acol, kind, sync; float alpha; int pad; };
constexpr int NGEMM = 13;
__device__ __forceinline__ GAS unsigned char* ldp(LAS unsigned char* lds, int i) {
    const LAS unsigned* t = (const LAS unsigned*)(lds + TAB_OFF) + 2 * i;
    const unsigned lo = __builtin_amdgcn_readfirstlane(t[0]), hi = __builtin_amdgcn_readfirstlane(t[1]);
    return (GAS unsigned char*)(((unsigned long long)hi << 32) | lo);
}

#define XBAR_ST_OFF (TAB_OFF + 2048)
#define GRID_BAR() do { XcdBarrier b_; b_.bar = (unsigned*)ldp(lds, 21); b_.x = xb_xcc_id(); b_.st = (volatile LAS unsigned*)(lds + XBAR_ST_OFF); xcd_barrier(b_); } while (0)
__global__ void __launch_bounds__(512, 2) yoco_fwd(Params P) {
    extern __shared__ __attribute__((aligned(16))) unsigned char lds_raw[];
    LAS unsigned char* lds = (LAS unsigned char*)lds_raw;
    cg::grid_group grid = cg::this_grid();
    const int tid = threadIdx.x, lane = tid & 63, wave = __builtin_amdgcn_readfirstlane(tid >> 6);
    const int G = gridDim.x, bx = blockIdx.x;
    const size_t WIN_E = (size_t)2 * FF * D, WOUT_E = (size_t)D * FF;

    if (tid == 0) { ((volatile LAS unsigned*)(lds + XBAR_ST_OFF))[0] = 0u; ((volatile LAS unsigned*)(lds + XBAR_ST_OFF))[1] = 0u; }
    (void)xcd_barrier_post((unsigned*)P.ws, (volatile LAS unsigned*)(lds + XBAR_ST_OFF));
    if (tid == 0) {
        LAS unsigned long long* pt = (LAS unsigned long long*)(lds + TAB_OFF);
#define PT(i) pt[i] = (unsigned long long)P.in[i]
        PT(0); PT(1); PT(2); PT(3); PT(4); PT(5); PT(6); PT(7); PT(8); PT(9); PT(10); PT(11); PT(12); PT(13); PT(14); PT(15); PT(16); PT(17); PT(18); PT(19);
#undef PT
        pt[20] = (unsigned long long)P.out; pt[21] = (unsigned long long)P.ws;
        const unsigned long long w = (unsigned long long)P.ws;
        LAS GD* gd = (LAS GD*)(lds + TAB_OFF + 256);
        const unsigned long long XBp = w + WS_XB, ACTp = w + WS_ACT, XFp = w + WS_XF, PBp = w + WS_PB, ZBp = w + WS_ZB;
#define SETG(i, A_, B_, P0_, P1_, N_, K_, LDA_, AC_, KIND_, SYNC_, AL_) do { LAS unsigned long long* q_ = (LAS unsigned long long*)(gd + (i)); q_[0] = (A_); q_[1] = (B_); q_[2] = (P0_); q_[3] = (P1_); LAS int* r_ = (LAS int*)(q_ + 4); r_[0] = (N_); r_[1] = (K_); r_[2] = (LDA_); r_[3] = (AC_); r_[4] = (KIND_); r_[5] = (SYNC_); ((LAS float*)r_)[6] = (AL_); r_[7] = 0; } while (0)
        SETG(0, XBp, w + WS_WIN, ACTp, 0ull, 2 * FF, D, D, 0, 0, 1, 0.f);
        SETG(1, ACTp, w + WS_WOUT, XFp, XBp, D, FF, FF, 0, 1, 1, 0.5f);
        SETG(2, PBp, w + WS_WPG, ZBp, 0ull, D, 256, D, 256, 2, 1, 0.f);
        SETG(3, ZBp, w + WS_WPO, XFp, XBp, D, D, D, 0, 1, 1, 1.0f);
        SETG(4, XBp, w + WS_WIN + WIN_BYTES, ACTp, 0ull, 2 * FF, D, D, 0, 0, 1, 0.f);
        SETG(5, ACTp, w + WS_WOUT + WOUT_BYTES, XFp, XBp, D, FF, FF, 0, 1, 1, 0.5f);
        SETG(6, XBp, w + WS_WKV, w + WS_KB, w + WS_VB, 2 * D, D, D, 0, 3, 0, 0.f);
        SETG(7, XBp, w + WS_WIN + 2 * WIN_BYTES, ACTp, 0ull, 2 * FF, D, D, 0, 0, 1, 0.f);
        SETG(8, ACTp, w + WS_WOUT + 2 * WOUT_BYTES, XFp, XBp, D, FF, FF, 0, 1, 1, 0.5f);
        SETG(9, XBp, w + WS_WQ, w + WS_QB, 0ull, NQ, D, D, 0, 4, 1, 0.f);
        SETG(10, PBp, w + WS_WO, XFp, XBp, D, D, D, 0, 1, 1, 1.0f);
        SETG(11, XBp, w + WS_WIN + 3 * WIN_BYTES, ACTp, 0ull, 2 * FF, D, D, 0, 0, 1, 0.f);
        SETG(12, ACTp, w + WS_WOUT + 3 * WOUT_BYTES, XFp, XBp, D, FF, FF, 0, 1, 1, 0.5f);
#undef SETG
    }
    __syncthreads();

    {
        const int gw = bx * 8 + wave, NGW = G * 8;
        const size_t gtid = (size_t)bx * 512 + tid, GT = (size_t)G * 512;
        GAS unsigned char* ws = (GAS unsigned char*)P.ws;
        GAS bf16_t* Win = (GAS bf16_t*)(ws + WS_WIN); GAS bf16_t* Wout = (GAS bf16_t*)(ws + WS_WOUT); GAS bf16_t* Wpg = (GAS bf16_t*)(ws + WS_WPG);
        LAS float* scr = (LAS float*)(lds + wave * 16384);
        transpose_matrix(P.in[6], D, 2 * FF, Win, 1, P.in[5], nullptr, scr, gw, NGW, lane);
        transpose_matrix(P.in[10], D, 2 * FF, Win + WIN_E, 1, P.in[9], nullptr, scr, gw, NGW, lane);
        transpose_matrix(P.in[6] + WIN_E, D, 2 * FF, Win + 2 * WIN_E, 1, P.in[5] + D, nullptr, scr, gw, NGW, lane);
        transpose_matrix(P.in[10] + WIN_E, D, 2 * FF, Win + 3 * WIN_E, 1, P.in[9] + D, nullptr, scr, gw, NGW, lane);
        transpose_matrix(P.in[7], FF, D, Wout, 0, nullptr, nullptr, scr, gw, NGW, lane);
        transpose_matrix(P.in[11], FF, D, Wout + WOUT_E, 0, nullptr, nullptr, scr, gw, NGW, lane);
        transpose_matrix(P.in[7] + WOUT_E, FF, D, Wout + 2 * WOUT_E, 0, nullptr, nullptr, scr, gw, NGW, lane);
        transpose_matrix(P.in[11] + WOUT_E, FF, D, Wout + 3 * WOUT_E, 0, nullptr, nullptr, scr, gw, NGW, lane);
        for (int gi = 0; gi < 4; ++gi) transpose_matrix(P.in[12] + (size_t)gi * 65536, 256, 256, Wpg + (size_t)gi * 65536, 0, nullptr, P.in[13] + gi * 256, scr, gw, NGW, lane);
        transpose_matrix(P.in[14], D, D, (GAS bf16_t*)(ws + WS_WPO), 0, nullptr, nullptr, scr, gw, NGW, lane);
        transpose_matrix(P.in[16], D, 2 * D, (GAS bf16_t*)(ws + WS_WKV), 0, P.in[15], nullptr, scr, gw, NGW, lane);
        transpose_matrix(P.in[17], D, NQ, (GAS bf16_t*)(ws + WS_WQ), 0, P.in[8] + D, nullptr, scr, gw, NGW, lane);
        transpose_matrix(P.in[18], D, D, (GAS bf16_t*)(ws + WS_WO), 0, nullptr, nullptr, scr, gw, NGW, lane);
        {
            const GAS float* x_prompt = (const GAS float*)P.in[0]; const GAS float* x_sample = (const GAS float*)P.in[1];
            GAS bf16_t* XB = (GAS bf16_t*)(ws + WS_XB); GAS float* ssq = (GAS float*)(ws + WS_SSQ);
            for (int row = gw; row < MV; row += NGW) {
                f32x4 v[4];
                if (row < MV) { const f32x4* xr = (const GAS f32x4*)(row < MP ? x_prompt + (size_t)row * D : x_sample + (size_t)(row - MP) * D) + lane;
#pragma unroll
                    for (int j = 0; j < 4; ++j) v[j] = xr[64 * j]; }
                else {
#pragma unroll
                    for (int j = 0; j < 4; ++j) v[j] = (f32x4){0.f, 0.f, 0.f, 0.f}; }
                float s = 0.f;
#pragma unroll
                for (int j = 0; j < 4; ++j) s += (v[j][0] * v[j][0] + v[j][1] * v[j][1]) + (v[j][2] * v[j][2] + v[j][3] * v[j][3]);
                s = wave_sum(s);
                u32x2* bo = (GAS u32x2*)(XB + (size_t)row * D) + lane;
#pragma unroll
                for (int j = 0; j < 4; ++j) { u32x2 w; w.x = cvt_pk_bf16(v[j][0], v[j][1]); w.y = cvt_pk_bf16(v[j][2], v[j][3]); bo[64 * j] = w; }
                if (lane < 16) ssq[(size_t)row * 16 + lane] = lane == 0 ? s : 0.f;
            }
        }
        {
            GAS float* rope = (GAS float*)(ws + WS_ROPE);
            for (size_t i = gtid; i < (size_t)(SEQ + 1) * 16; i += GT) {
                const int pi = (int)(i >> 4), fi = (int)(i & 15); const double pos = pi < SEQ ? (double)pi : 16384.0;
                double iv = P.invf[0];
#define IV(k) if (fi == k) iv = P.invf[k]
                IV(1); IV(2); IV(3); IV(4); IV(5); IV(6); IV(7); IV(8); IV(9); IV(10); IV(11); IV(12); IV(13); IV(14); IV(15);
#undef IV
                double s, c; sincos_d(pos * iv, s, c);
                rope[(size_t)pi * 32 + fi] = (float)c; rope[(size_t)pi * 32 + 16 + fi] = (float)s;
            }
        }
        {
            constexpr unsigned per_b = (unsigned)(WMAX - 1) * D / 4, full_b = (unsigned)WMAX * D / 4;
            constexpr unsigned tot = 2u * NS * per_b;
            const GAS f32x4* sk = (const GAS f32x4*)P.in[3]; const GAS f32x4* sv = (const GAS f32x4*)P.in[4];
            GAS f32x4* dk = (GAS f32x4*)(P.out + O_CKS); GAS f32x4* dv = (GAS f32x4*)(P.out + O_CVS);
            const unsigned GTu = (unsigned)GT;
            for (unsigned j0 = (unsigned)gtid; j0 < tot; j0 += 8u * GTu) {
                f32x4 v[8];
#pragma unroll
                for (int q = 0; q < 8; ++q) { const unsigned j = j0 + (unsigned)q * GTu; if (j < tot) { const unsigned ck = j / per_b, r = j - ck * per_b, b = ck >> 1;
                        const GAS f32x4* s = ((ck & 1) ? sv : sk) + (size_t)b * full_b + (D / 4) + r; v[q] = __builtin_nontemporal_load(s); } }
#pragma unroll
                for (int q = 0; q < 8; ++q) { const unsigned j = j0 + (unsigned)q * GTu; if (j < tot) { const unsigned ck = j / per_b, r = j - ck * per_b, b = ck >> 1;
                        GAS f32x4* d = ((ck & 1) ? dv : dk) + (size_t)b * full_b + r; __builtin_nontemporal_store(v[q], d); } }
            }
        }
    }
    if (G == 0x7fffffff) grid.sync();
    GRID_BAR();

    for (int gi = 0; gi < NGEMM; ++gi) {
        if (gi == 2) {
            int t_ = threadIdx.x; asm volatile("" : "+v"(t_)); const int tid = t_, lane = tid & 63, wave = __builtin_amdgcn_readfirstlane(tid >> 6); (void)lane; (void)wave;
            GAS unsigned char* ws = ldp(lds, 21); GAS float* out = (GAS float*)ldp(lds, 20);
            const GAS float* mix_norm = (const GAS float*)ldp(lds, 8); const GAS float* state_pool = (const GAS float*)ldp(lds, 2);
            const GAS float* ssq = (const GAS float*)(ws + WS_SSQ); const GAS bf16_t* XB = (const GAS bf16_t*)(ws + WS_XB); GAS bf16_t* PBUF = (GAS bf16_t*)(ws + WS_PB);
#define LDH(r_) ({ const u32x2 q_ = *(const GAS u32x2*)(XB + (size_t)(r_) * D + 4 * cq); (f32x4){__uint_as_float(q_.x << 16), __uint_as_float(q_.x & 0xffff0000u), __uint_as_float(q_.y << 16), __uint_as_float(q_.y & 0xffff0000u)}; })
            LAS float* rr = (LAS float*)lds;
            for (int unit = bx; unit < MP / 64 + NS; unit += G) {
                __syncthreads();
                if (unit < MP / 64) {
                    const int R0 = unit * 64, b = R0 >> 13, t0 = R0 & (SEQ - 1);
                    if (tid < 80) { const int tt = tid - 16; float r = 0.f;
                        if (t0 + tt >= 0) { const GAS float* sp = ssq + (size_t)(R0 + tt) * 16; float s = 0.f;
#pragma unroll
                            for (int j = 0; j < 16; ++j) s += sp[j];
                            r = rsqrtf(s * (1.0f / D) + RMS_EPS); }
                        rr[tid] = r; }
                    __syncthreads();
                    const int cq = tid & 255, half = tid >> 8, gq = cq >> 6, w = 2 << gq;
                    const f32x4 gm = *(const GAS f32x4*)(mix_norm + 4 * cq);
                    const int s0 = half * 32;
                    f32x4 win = (f32x4){0.f, 0.f, 0.f, 0.f};
                    for (int i = 1; i < w; ++i) { const int tt = s0 - i; if (t0 + tt >= 0) win += LDH(R0 + tt) * rr[tt + 16] * gm; }
#pragma unroll 8
                    for (int tt = s0; tt < s0 + 32; ++tt) {
                        const f32x4 hc = LDH(R0 + tt) * rr[tt + 16] * gm;
                        win += hc;
                        const int t = t0 + tt; const float inv = 1.0f / (float)(t + 1 < w ? t + 1 : w);
                        const f32x4 p = win * inv - hc;
                        u32x2 o; o.x = cvt_pk_bf16(p[0], p[1]); o.y = cvt_pk_bf16(p[2], p[3]);
                        *(GAS u32x2*)(PBUF + (size_t)(R0 + tt) * D + 4 * cq) = o;
                        if (t >= SEQ - PB) *(GAS f32x4*)(out + O_SPP + ((size_t)b * PB + (t - (SEQ - PB))) * D + 4 * cq) = hc;
                        const int to = tt - w + 1; if (t0 + to >= 0) win -= LDH(R0 + to) * rr[to + 16] * gm;
                    }
                } else {
                    const int sb = unit - MP / 64, row = MP + sb;
                    if (tid < 256) {
                        const int cq = tid, gq = cq >> 6, w = 2 << gq;
                        const GAS float* sp = ssq + (size_t)row * 16; float s = 0.f;
#pragma unroll
                        for (int j = 0; j < 16; ++j) s += sp[j];
                        const float r = rsqrtf(s * (1.0f / D) + RMS_EPS);
                        const f32x4 gm = *(const GAS f32x4*)(mix_norm + 4 * cq);
                        const f32x4 hn = LDH(row) * r * gm;
                        f32x4 win = hn;
                        for (int i = 0; i < PB; ++i) {
                            const f32x4 pv = *(const GAS f32x4*)(state_pool + ((size_t)sb * PB + i) * D + 4 * cq);
                            if (i >= PB - (w - 1)) win += pv;
                            if (i >= 1) *(GAS f32x4*)(out + O_SPS + ((size_t)sb * PB + (i - 1)) * D + 4 * cq) = pv;
                        }
                        *(GAS f32x4*)(out + O_SPS + ((size_t)sb * PB + (PB - 1)) * D + 4 * cq) = hn;
                        const f32x4 p = win * (1.0f / (float)w) - hn;
                        u32x2 o; o.x = cvt_pk_bf16(p[0], p[1]); o.y = cvt_pk_bf16(p[2], p[3]);
                        *(GAS u32x2*)(PBUF + (size_t)row * D + 4 * cq) = o;
                    }
                }
            }
            GRID_BAR();
        }
        if (gi == 10) {
            {
                int t_ = threadIdx.x; asm volatile("" : "+v"(t_)); const int tid = t_, lane = tid & 63, wave = __builtin_amdgcn_readfirstlane(tid >> 6);
                GAS unsigned char* ws = ldp(lds, 21);
                const GAS bf16_t* KB = (const GAS bf16_t*)(ws + WS_KB); const GAS bf16_t* VB = (const GAS bf16_t*)(ws + WS_VB); const GAS bf16_t* QB = (const GAS bf16_t*)(ws + WS_QB);
                GAS bf16_t* OG = (GAS bf16_t*)(ws + WS_OG); GAS float* lse = (GAS float*)(ws + WS_LSE);
                const int qi = lane & 15, qd = lane >> 4;
                const int per = (6144 + G - 1) / G, u0 = bx * per, u1 = (u0 + per < 6144) ? u0 + per : 6144;
                u32x4 kr[4], vr[4]; bf16x8 qn[4];
#define DEC(u_, gq_, b_, h_, cls_, n_, dl_) const int gq_ = (u_) / 2048, b_ = ((u_) >> 9) & 3, h_ = ((u_) >> 6) & 7, blk_##u_ = (u_) & 63; const int dl_ = gq_ == 0 ? 1 : (gq_ == 1 ? 4 : 16); const int nbk_##u_ = 64 / dl_, cls_ = blk_##u_ / nbk_##u_, n_ = blk_##u_ % nbk_##u_
#define ISSUE(gq_, b_, h_, cls_, n_, dl_) do { \
                    _Pragma("unroll") for (int i = 0; i < 4; ++i) { const int c = tid + 512 * i, row = c >> 4, ch = c & 15; \
                        const size_t so = ((size_t)(b_) * SEQ + (size_t)((128 * (n_) + row) * (dl_) + (cls_))) * D + (h_) * HD + ch * 8; kr[i] = *(const GAS u32x4*)(KB + so); vr[i] = *(const GAS u32x4*)(VB + so); } \
                    { const size_t qrow_ = (size_t)(b_) * SEQ + (size_t)((128 * (n_) + 16 * wave + qi) * (dl_) + (cls_)); \
                      _Pragma("unroll") for (int s = 0; s < 4; ++s) qn[s] = *(const GAS bf16x8*)(QB + qrow_ * NQ + ((gq_) * 8 + (h_)) * HD + 32 * s + 8 * qd); } } while (0)
                int rot = 0; bool chained = false;
                { const int uu = u0 < 6144 ? u0 : 6143; DEC(uu, g0, b0, h0, c0, n0, d0); ISSUE(g0, b0, h0, c0, n0, d0); }
                for (int u = u0; u < u1; ++u) {
                    DEC(u, gq, b, h, cls, n, dl);
                    __syncthreads();
                    {
                        const unsigned rx = (unsigned)rot << 15;
#pragma unroll
                        for (int i = 0; i < 4; ++i) { const int c = tid + 512 * i, row = c >> 4, ch = c & 15;
                            const unsigned oo = (unsigned)kv_off(128 + row, ch) ^ rx; *(LAS u32x4*)(lds + oo) = kr[i]; *(LAS u32x4*)(lds + 65536 + oo) = vr[i];
                        }
                        if (!chained) {
#pragma unroll
                            for (int i = 0; i < 4; ++i) { const int c = tid + 512 * i, row = c >> 4, ch = c & 15;
                                u32x4 kp = (u32x4){0u, 0u, 0u, 0u}, vp = (u32x4){0u, 0u, 0u, 0u};
                                if (n > 0) { const size_t sp = ((size_t)b * SEQ + (size_t)((128 * (n - 1) + row) * dl + cls)) * D + h * HD + ch * 8; kp = *(const GAS u32x4*)(KB + sp); vp = *(const GAS u32x4*)(VB + sp); }
                                const unsigned op = (unsigned)kv_off(row, ch) ^ rx; *(LAS u32x4*)(lds + op) = kp; *(LAS u32x4*)(lds + 65536 + op) = vp; }
                        }
                    }
                    bf16x8 qf[4];
#pragma unroll
                    for (int s = 0; s < 4; ++s) qf[s] = qn[s];
                    __syncthreads();
                    const int rotc = rot;
                    { const int un = (u + 1 < u1) ? u + 1 : u;
                      DEC(un, g1, b1, h1, c1, n1, d1); const bool ch1 = (n1 != 0) && ((un & 63) != 0) && (un != u);
                      ISSUE(g1, b1, h1, c1, n1, d1);
                      chained = ch1; rot = ch1 ? (rot ^ 1) : 0; }
                    const unsigned rx = (unsigned)rotc << 15;
                    const int ii = 16 * wave + qi; const size_t qrow = (size_t)b * SEQ + (size_t)((128 * n + ii) * dl + cls);
                    const int kw = 16 * wave;
                    f32x4 Sx[9];
                    {
                        bf16x8 kf[2][4];
#pragma unroll
                        for (int s = 0; s < 4; ++s) kf[0][s] = *(const LAS bf16x8*)(lds + ((unsigned)kv_off(kw + qi, 4 * s + qd) ^ rx));
#pragma unroll
                        for (int j = 0; j < 9; ++j) {
                            if (j < 8) {
#pragma unroll
                                for (int s = 0; s < 4; ++s) kf[(j + 1) & 1][s] = *(const LAS bf16x8*)(lds + ((unsigned)kv_off(kw + 16 * (j + 1) + qi, 4 * s + qd) ^ rx));
                            }
                            f32x4 a = (f32x4){0.f, 0.f, 0.f, 0.f};
#pragma unroll
                            for (int s = 0; s < 4; ++s) a = __builtin_amdgcn_mfma_f32_16x16x32_bf16(kf[j & 1][s], qf[s], a, 0, 0, 0);
                            if (j == 0) {
#pragma unroll
                                for (int e = 0; e < 4; ++e) a[e] = (4 * qd + e >= qi) ? a[e] : -INFINITY; }
                            if (j == 8) {
#pragma unroll
                                for (int e = 0; e < 4; ++e) a[e] = (4 * qd + e <= qi) ? a[e] : -INFINITY; }
                            Sx[j] = a;
                        }
                    }
                    if (n == 0) {
#pragma unroll
                        for (int j = 0; j < 8; ++j) if (wave + j < 8) Sx[j] = (f32x4){-INFINITY, -INFINITY, -INFINITY, -INFINITY};
                    }
                    float mx = -INFINITY;
#pragma unroll
                    for (int kt = 0; kt < 9; ++kt) mx = fmaxf(mx, fmaxf(fmaxf(Sx[kt][0], Sx[kt][1]), fmaxf(Sx[kt][2], Sx[kt][3])));
                    mx = fmaxf(mx, __shfl_xor(mx, 16)); mx = fmaxf(mx, __shfl_xor(mx, 32));
                    float ls = 0.f;
#pragma unroll
                    for (int kt = 0; kt < 9; ++kt)
#pragma unroll
                        for (int e = 0; e < 4; ++e) { const float p = __builtin_amdgcn_exp2f(Sx[kt][e] - mx); Sx[kt][e] = p; ls += p; }
                    ls += __shfl_xor(ls, 16); ls += __shfl_xor(ls, 32);
                    f32x4 O[8];
#pragma unroll
                    for (int dt = 0; dt < 8; ++dt) O[dt] = (f32x4){0.f, 0.f, 0.f, 0.f};
                    const int q4 = qi >> 2, p4 = qi & 3, sw = (q4 << 2) | qd;
                    const unsigned vlane = 65536u + 256u * (unsigned)(4 * qd + q4) + 8u * (unsigned)(p4 & 1);
#define TRR(dst, addr) asm volatile("ds_read_b64_tr_b16 %0, %1" : "=&v"(dst) : "v"(addr) : "memory")
#define TRBATCH(i_, L_, H_) do { const int ks_ = (i_) >> 1, dh_ = (i_) & 1; const int tl_ = 2 * ks_, th_ = (2 * ks_ + 1 < 9) ? 2 * ks_ + 1 : 8; \
                        const unsigned blo_ = ((256u * (unsigned)(kw + 16 * tl_)) ^ rx) + vlane, bhi_ = ((256u * (unsigned)(kw + 16 * th_)) ^ rx) + vlane; \
                        _Pragma("unroll") for (int d4 = 0; d4 < 4; ++d4) { const int dt_ = 4 * dh_ + d4; const unsigned co_ = 16u * (unsigned)((2 * dt_ + (p4 >> 1)) ^ sw); const unsigned a0_ = blo_ + co_, a1_ = bhi_ + co_; TRR(L_[d4], a0_); TRR(H_[d4], a1_); } } while (0)
#define PVMMA(i_, L_, H_) do { const int ks_ = (i_) >> 1, dh_ = (i_) & 1; \
                        bf16x8 pf_; { u32x4 t_; t_.x = cvt_pk_bf16(Sx[2 * ks_][0], Sx[2 * ks_][1]); t_.y = cvt_pk_bf16(Sx[2 * ks_][2], Sx[2 * ks_][3]); \
                            if (2 * ks_ + 1 < 9) { t_.z = cvt_pk_bf16(Sx[(2 * ks_ + 1 < 9) ? 2 * ks_ + 1 : 8][0], Sx[(2 * ks_ + 1 < 9) ? 2 * ks_ + 1 : 8][1]); t_.w = cvt_pk_bf16(Sx[(2 * ks_ + 1 < 9) ? 2 * ks_ + 1 : 8][2], Sx[(2 * ks_ + 1 < 9) ? 2 * ks_ + 1 : 8][3]); } else { t_.z = 0u; t_.w = 0u; } \
                            pf_ = __builtin_bit_cast(bf16x8, t_); } \
                        _Pragma("unroll") for (int d4 = 0; d4 < 4; ++d4) { const int dt_ = 4 * dh_ + d4; const bf16x8 vf_ = (bf16x8){L_[d4][0], L_[d4][1], L_[d4][2], L_[d4][3], H_[d4][0], H_[d4][1], H_[d4][2], H_[d4][3]}; \
                            O[dt_] = __builtin_amdgcn_mfma_f32_16x16x32_bf16(vf_, pf_, O[dt_], 0, 0, 0); } } while (0)
#define TRWAIT(cnt_, L_, H_) asm volatile("s_waitcnt lgkmcnt(" #cnt_ ")" : "+v"(L_[0]), "+v"(L_[1]), "+v"(L_[2]), "+v"(L_[3]), "+v"(H_[0]), "+v"(H_[1]), "+v"(H_[2]), "+v"(H_[3]) :: "memory")
                    {
                        s16x4 la[4], ha[4], lb[4], hb[4];
                        TRBATCH(0, la, ha);
                        TRBATCH(1, lb, hb); TRWAIT(8, la, ha); PVMMA(0, la, ha);
                        TRBATCH(2, la, ha); TRWAIT(8, lb, hb); PVMMA(1, lb, hb);
                        TRBATCH(3, lb, hb); TRWAIT(8, la, ha); PVMMA(2, la, ha);
                        TRBATCH(4, la, ha); TRWAIT(8, lb, hb); PVMMA(3, lb, hb);
                        TRBATCH(5, lb, hb); TRWAIT(8, la, ha); PVMMA(4, la, ha);
                        TRBATCH(6, la, ha); TRWAIT(8, lb, hb); PVMMA(5, lb, hb);
                        TRBATCH(7, lb, hb); TRWAIT(8, la, ha); PVMMA(6, la, ha);
                        TRBATCH(8, la, ha); TRWAIT(8, lb, hb); PVMMA(7, lb, hb);
                        TRBATCH(9, lb, hb); TRWAIT(8, la, ha); PVMMA(8, la, ha);
                        TRWAIT(0, lb, hb); PVMMA(9, lb, hb);
                    }
#undef TRWAIT
#undef PVMMA
#undef TRBATCH
#undef TRR
                    const float inv = 1.0f / ls;
                    GAS bf16_t* od = OG + ((size_t)gq * MT + qrow) * D + h * HD + 4 * qd;
#pragma unroll
                    for (int dt = 0; dt < 8; ++dt) { u32x2 w; w.x = cvt_pk_bf16(O[dt][0] * inv, O[dt][1] * inv); w.y = cvt_pk_bf16(O[dt][2] * inv, O[dt][3] * inv); *(GAS u32x2*)(od + 16 * dt) = w; }
                    if (qd == 0) lse[((size_t)gq * MT + qrow) * 8 + h] = mx + __builtin_amdgcn_logf(ls);
                }
#undef ISSUE
#undef DEC
            }
            {
                int t_ = threadIdx.x; asm volatile("" : "+v"(t_)); const int tid = t_, lane = tid & 63, wave = __builtin_amdgcn_readfirstlane(tid >> 6);
                GAS unsigned char* ws = ldp(lds, 21); const GAS float* out = (const GAS float*)ldp(lds, 20);
                const GAS float* cache_k = (const GAS float*)ldp(lds, 3); const GAS float* cache_v = (const GAS float*)ldp(lds, 4);
                const GAS bf16_t* QB = (const GAS bf16_t*)(ws + WS_QB); GAS bf16_t* PBUF = (GAS bf16_t*)(ws + WS_PB);
                LAS float* sc = (LAS float*)lds;
                LAS f32x4* red = (LAS f32x4*)(lds + 2048);
                for (int unit = bx; unit < NS * NH; unit += G) {
                    const int b = unit >> 3, h = unit & 7;
                    __syncthreads();
                    const int l16 = lane & 15, kq = lane >> 4;
#pragma unroll
                    for (int pass = 0; pass < 13; ++pass) {
                        const int pi = pass * 32 + wave * 4 + kq, pc = pi < 387 ? pi : 386;
                        const int gq = pc / 129, j = pc % 129, dl = gq == 0 ? 1 : (gq == 1 ? 4 : 16);
                        const GAS float* kp = (j == 0) ? out + O_CKS + ((size_t)b * WMAX + (WMAX - 1)) * D : cache_k + ((size_t)b * WMAX + (WMAX - dl * j)) * D;
                        const f32x4 k0 = *(const GAS f32x4*)(kp + h * HD + 8 * l16), k1 = *(const GAS f32x4*)(kp + h * HD + 8 * l16 + 4);
                        const u32x4 qv = *(const GAS u32x4*)(QB + (size_t)(MP + b) * NQ + (gq * 8 + h) * HD + 8 * l16);
                        float s = k0[0] * __uint_as_float(qv.x << 16) + k0[1] * __uint_as_float(qv.x & 0xffff0000u) + k0[2] * __uint_as_float(qv.y << 16) + k0[3] * __uint_as_float(qv.y & 0xffff0000u)
                                + k1[0] * __uint_as_float(qv.z << 16) + k1[1] * __uint_as_float(qv.z & 0xffff0000u) + k1[2] * __uint_as_float(qv.w << 16) + k1[3] * __uint_as_float(qv.w & 0xffff0000u);
                        s += __shfl_xor(s, 1); s += __shfl_xor(s, 2); s += __shfl_xor(s, 4); s += __shfl_xor(s, 8);
                        if (l16 == 0 && pi < 387) sc[pi] = s;
                    }
                    __syncthreads();
                    if (wave == 0) {
                        float v[7]; float mx = -INFINITY;
#pragma unroll
                        for (int i = 0; i < 7; ++i) { const int pi = lane + 64 * i; v[i] = pi < 387 ? sc[pi] : -INFINITY; mx = fmaxf(mx, v[i]); }
                        mx = wave_max(mx); float ls = 0.f;
#pragma unroll
                        for (int i = 0; i < 7; ++i) { const int pi = lane + 64 * i; const float p = __builtin_amdgcn_exp2f(v[i] - mx); ls += p; if (pi < 387) sc[pi] = p; }
                        ls = wave_sum(ls);
                        if (lane == 0) sc[500] = 1.0f / ls;
                    }
                    __syncthreads();
                    {
                        const int part = tid >> 5, d4 = (tid & 31) * 4; f32x4 acc = (f32x4){0.f, 0.f, 0.f, 0.f};
#pragma unroll 5
                        for (int it = 0; it < 25; ++it) {
                            const int pi = part + 16 * it, pc = pi < 387 ? pi : 386;
                            const int gq = pc / 129, j = pc % 129, dl = gq == 0 ? 1 : (gq == 1 ? 4 : 16);
                            const GAS float* vp = (j == 0) ? out + O_CVS + ((size_t)b * WMAX + (WMAX - 1)) * D : cache_v + ((size_t)b * WMAX + (WMAX - dl * j)) * D;
                            const float p = pi < 387 ? sc[pc] : 0.f;
                            acc += *(const GAS f32x4*)(vp + h * HD + d4) * p;
                        }
                        red[part * 32 + (tid & 31)] = acc;
                    }
                    __syncthreads();
                    if (tid < 128) { const LAS float* rf = (const LAS float*)red; float o = 0.f;
#pragma unroll
                        for (int pt = 0; pt < 16; ++pt) o += rf[pt * 128 + tid];
                        o *= sc[500];
                        PBUF[(size_t)(MP + b) * D + h * HD + tid] = (bf16_t)(cvt_pk_bf16(o, 0.f) & 0xffffu); }
                }
            }
            GRID_BAR();
            {
                int t_ = threadIdx.x; asm volatile("" : "+v"(t_)); const int tid = t_, lane = tid & 63, wave = __builtin_amdgcn_readfirstlane(tid >> 6); (void)lane; (void)wave;
                GAS unsigned char* ws = ldp(lds, 21);
                const GAS bf16_t* OG = (const GAS bf16_t*)(ws + WS_OG); const GAS float* lse = (const GAS float*)(ws + WS_LSE); GAS bf16_t* PBUF = (GAS bf16_t*)(ws + WS_PB);
                const size_t gtid = (size_t)bx * 512 + tid, GT = (size_t)G * 512;
                for (size_t i = gtid; i < (size_t)MP * 128; i += GT) {
                    const size_t row = i >> 7; const int ch = (int)(i & 127), h = ch >> 4;
                    const float l0 = lse[((size_t)0 * MT + row) * 8 + h], l1 = lse[((size_t)1 * MT + row) * 8 + h], l2 = lse[((size_t)2 * MT + row) * 8 + h];
                    const float m = fmaxf(l0, fmaxf(l1, l2));
                    float w0 = __builtin_amdgcn_exp2f(l0 - m), w1 = __builtin_amdgcn_exp2f(l1 - m), w2 = __builtin_amdgcn_exp2f(l2 - m);
                    const float inv = 1.0f / (w0 + w1 + w2); w0 *= inv; w1 *= inv; w2 *= inv;
                    const u32x4 a = *(const GAS u32x4*)(OG + ((size_t)0 * MT + row) * D + ch * 8), bb = *(const GAS u32x4*)(OG + ((size_t)1 * MT + row) * D + ch * 8), c = *(const GAS u32x4*)(OG + ((size_t)2 * MT + row) * D + ch * 8);
                    u32x4 o;
#pragma unroll
                    for (int e = 0; e < 4; ++e) {
                        const float lo = w0 * __uint_as_float(a[e] << 16) + w1 * __uint_as_float(bb[e] << 16) + w2 * __uint_as_float(c[e] << 16);
                        const float hi = w0 * __uint_as_float(a[e] & 0xffff0000u) + w1 * __uint_as_float(bb[e] & 0xffff0000u) + w2 * __uint_as_float(c[e] & 0xffff0000u);
                        o[e] = cvt_pk_bf16(lo, hi);
                    }
                    *(GAS u32x4*)(PBUF + row * D + ch * 8) = o;
                }
            }
            GRID_BAR();
        }
        {
            const LAS unsigned* wv = (const LAS unsigned*)(lds + TAB_OFF + 256 + gi * 64);
            unsigned v[16];
#pragma unroll
            for (int j = 0; j < 16; ++j) v[j] = __builtin_amdgcn_readfirstlane(wv[j]);
#define U64(a, b) (((unsigned long long)(b) << 32) | (a))
            pg8::Gemm g{(const GAS bf16_t*)U64(v[0], v[1]), (const GAS bf16_t*)U64(v[2], v[3]), MP, (int)v[8], (int)v[9], (int)v[10], (int)v[11]};
            GAS unsigned char* ws = ldp(lds, 21);
            EpiAll E{(int)v[12], (GAS void*)U64(v[4], v[5]), (GAS void*)U64(v[6], v[7]), (GAS float*)(ws + WS_SSQ), (const GAS float*)(ws + WS_ROPE), (GAS float*)ldp(lds, 20), __uint_as_float(v[14])};
#undef U64
            { const int item = G - 1 - bx; if (item < (g.N >> 6)) skinny_item(lds, g, E, item); }
            pg8::StaticOrder S; S.init(MP, g.N, G, bx);
            pg8::gemm_phase(lds, g, S, E);
            if (v[13]) GRID_BAR();
        }
    }
    {
        int t_ = threadIdx.x; asm volatile("" : "+v"(t_)); const int tid = t_, lane = tid & 63, wave = __builtin_amdgcn_readfirstlane(tid >> 6);
        GAS unsigned char* ws = ldp(lds, 21); GAS float* out = (GAS float*)ldp(lds, 20); const GAS float* final_norm = (const GAS float*)ldp(lds, 19);
        const GAS float* ssq = (const GAS float*)(ws + WS_SSQ); const GAS bf16_t* XB = (const GAS bf16_t*)(ws + WS_XB);
        const int gw = bx * 8 + wave, NGW = G * 8;
        const GAS f32x4* gn = (const GAS f32x4*)final_norm + lane;
        const f32x4 g0 = gn[0], g1 = gn[64], g2 = gn[128], g3 = gn[192];
#pragma unroll 2
        for (int row = gw; row < MV; row += NGW) {
            const f32x4 s4 = *(const GAS f32x4*)(ssq + (size_t)row * 16 + 4 * (lane & 3));
            float s = (s4[0] + s4[1]) + (s4[2] + s4[3]); s += __shfl_xor(s, 1); s += __shfl_xor(s, 2);
            const float r = rsqrtf(s * (1.0f / D) + RMS_EPS);
            const GAS u32x2* xr = (const GAS u32x2*)(XB + (size_t)row * D) + lane;
            GAS f32x4* yo = (GAS f32x4*)(out + (size_t)row * D) + lane;
            const u32x2 q0 = xr[0], q1 = xr[64], q2 = xr[128], q3 = xr[192];
#define UNPK(q_) ((f32x4){__uint_as_float((q_).x << 16), __uint_as_float((q_).x & 0xffff0000u), __uint_as_float((q_).y << 16), __uint_as_float((q_).y & 0xffff0000u)})
            __builtin_nontemporal_store(UNPK(q0) * r * g0, yo); __builtin_nontemporal_store(UNPK(q1) * r * g1, yo + 64);
            __builtin_nontemporal_store(UNPK(q2) * r * g2, yo + 128); __builtin_nontemporal_store(UNPK(q3) * r * g3, yo + 192);
#undef UNPK
        }
    }
}

extern "C" void kernel_launch(void* const* d_in, const int* in_sizes, int n_in, void* d_out, int out_size, void* d_ws, size_t ws_size, hipStream_t stream) {
    static int grid = 0;
    if (grid == 0) {
        if (n_in != 20 || ws_size < WS_END) { fprintf(stderr, "kernel_launch: unexpected n_in %d / ws %zu (need %zu)\n", n_in, ws_size, (size_t)WS_END); grid = -1; return; }
        int dev = 0, cus = 0, per_cu = 0;
        hipGetDevice(&dev); hipDeviceGetAttribute(&cus, hipDeviceAttributeMultiprocessorCount, dev);
        hipFuncSetAttribute((const void*)yoco_fwd, hipFuncAttributeMaxDynamicSharedMemorySize, LDS_BYTES);
        hipOccupancyMaxActiveBlocksPerMultiprocessor(&per_cu, (const void*)yoco_fwd, 512, LDS_BYTES);
        if (per_cu < 1) { fprintf(stderr, "kernel_launch: occupancy query says %d blocks/CU\n", per_cu); per_cu = 1; }
        (void)hipGetLastError();
        grid = cus * 1;
    }
    if (grid < 0) return;
    Params p{};
    for (int i = 0; i < 20; ++i) p.in[i] = (const float*)d_in[i];
    p.out = (float*)d_out; p.ws = (unsigned char*)d_ws;
    static const double invf[16] = {1.0, 0.44036660267178046, 0.19392274474868576, 0.08539710028576561, 0.03760603093086393, 0.016560440080994446, 0.007292664737217109, 0.003211445994752591,
                                    0.001414213562373095, 0.000622772421914596, 0.0002742481756762073, 0.00012076973741146504, 5.318295896944988e-05, 2.341999896140934e-05, 1.031338537721246e-05, 4.5416704806078695e-06};
    for (int i = 0; i < 16; ++i) p.invf[i] = invf[i];
    (void)hipMemsetAsync(d_ws, 0, 16384, stream);
    void* args[] = {&p};
    hipError_t e = hipLaunchCooperativeKernel((const void*)yoco_fwd, dim3(grid), dim3(512), args, LDS_BYTES, stream);
    if (e != hipSuccess) fprintf(stderr, "cooperative launch failed: %s (grid %d)\n", hipGetErrorString(e), grid);
}
```

```cpp
#include <hip/hip_runtime.h>
#include <hip/hip_cooperative_groups.h>
#include <cstdio>
#include <cstdint>
namespace cg = cooperative_groups;

#define LAS __attribute__((address_space(3)))
#if defined(__HIP_DEVICE_COMPILE__)
#define GAS __attribute__((address_space(1)))
#else
#define GAS
#endif
typedef unsigned short bf16_t;
typedef short bf16x8 __attribute__((ext_vector_type(8)));
typedef short s16x4 __attribute__((ext_vector_type(4)));
typedef float f32x4 __attribute__((ext_vector_type(4)));
typedef float f32x2 __attribute__((ext_vector_type(2)));
typedef unsigned u32x4 __attribute__((ext_vector_type(4)));
typedef unsigned u32x2 __attribute__((ext_vector_type(2)));

constexpr int D = 1024, FF = 2816, NB = 4, SEQ = 8192, MP = NB * SEQ  , NS = 32  ;
constexpr int MT = MP + 256;
constexpr int MV = MP + NS;
constexpr int NH = 8, HD = 128, WMAX = 2048, PB = 15;
constexpr int NQ = 3 * D;
constexpr float RMS_EPS = 1e-6f;
constexpr float QSCALE = 0.08838834764831845f * 1.4426950408889634f;

constexpr size_t O_YP = 0, O_YS = (size_t)MP * D, O_SPP = O_YS + (size_t)NS * D, O_SPS = O_SPP + (size_t)NB * PB * D,
                 O_CKP = O_SPS + (size_t)NS * PB * D, O_CVP = O_CKP + (size_t)NB * WMAX * D, O_CKS = O_CVP + (size_t)NB * WMAX * D,
                 O_CVS = O_CKS + (size_t)NS * WMAX * D;

constexpr size_t MiB = 1u << 20;
constexpr size_t WS_WIN = 1 * MiB;
constexpr size_t WIN_BYTES = (size_t)2 * FF * D * 2;
constexpr size_t WS_WOUT = WS_WIN + 4 * WIN_BYTES;
constexpr size_t WOUT_BYTES = (size_t)D * FF * 2;
constexpr size_t WS_WPG = WS_WOUT + 4 * WOUT_BYTES;
constexpr size_t WS_WPO = WS_WPG + (size_t)D * 256 * 2;
constexpr size_t WS_WKV = WS_WPO + (size_t)D * D * 2;
constexpr size_t WS_WQ = WS_WKV + (size_t)2 * D * D * 2;
constexpr size_t WS_WO = WS_WQ + (size_t)NQ * D * 2;
constexpr size_t WS_ROPE = WS_WO + (size_t)D * D * 2;
constexpr size_t WS_SSQ = WS_ROPE + (size_t)8200 * 32 * 4;
constexpr size_t WS_LSE = WS_SSQ + (size_t)MT * 16 * 4;
constexpr size_t WS_XF = (WS_LSE + (size_t)3 * MT * 8 * 4 + 4095) & ~(size_t)4095;
constexpr size_t WS_XB = WS_XF + (size_t)MT * D * 4;
constexpr size_t WS_ACT = WS_XB + (size_t)MT * D * 2;
constexpr size_t WS_PB = WS_ACT + (size_t)MT * FF * 2;
constexpr size_t WS_ZB = WS_PB + (size_t)MT * D * 2;
constexpr size_t WS_KB = WS_ZB + (size_t)MT * D * 2;
constexpr size_t WS_VB = WS_KB + (size_t)MT * D * 2;
constexpr size_t WS_QB = WS_VB + (size_t)MT * D * 2;
constexpr size_t WS_OG = WS_QB + (size_t)MT * NQ * 2;
constexpr size_t WS_END = WS_OG + (size_t)3 * MT * D * 2;

constexpr int LDS_BYTES = 147456;

struct Params {
    const float* in[20];
    float* out;
    unsigned char* ws;
    double invf[16];
};

__device__ __forceinline__ unsigned cvt_pk_bf16(float lo, float hi) { unsigned r; asm volatile("v_cvt_pk_bf16_f32 %0, %1, %2" : "=v"(r) : "v"(lo), "v"(hi)); return r; }
__device__ __forceinline__ float bf2f(unsigned short b) { return __uint_as_float((unsigned)b << 16); }
__device__ __forceinline__ float wave_sum(float v) {
#pragma unroll
    for (int o = 1; o < 64; o <<= 1) v += __shfl_xor(v, o);
    return v;
}
__device__ __forceinline__ float wave_max(float v) {
#pragma unroll
    for (int o = 1; o < 64; o <<= 1) v = fmaxf(v, __shfl_xor(v, o));
    return v;
}

namespace pg8 {
constexpr int BM = 256, BK = 64, HALF = 128, HTB = HALF * BK * 2, STAGE_BYTES = 8 * HTB, NXCD = 8, WGM = 8;
__host__ __device__ __forceinline__ int lds_byte(int r, int c) { const int st = (r >> 4) * 2 + (c >> 5), rr = r & 15, cc = c & 31, ob = rr * 64 + cc * 2; return st * 1024 + (ob ^ (((ob >> 9) & 1) << 5)); }
__host__ __device__ __forceinline__ void stage_rc(int b, int& R, int& C) { const int st = b / 1024, sb = b % 1024, swz = sb ^ (((sb >> 9) & 1) << 5); R = (st >> 1) * 16 + swz / 64; C = (st & 1) * 32 + (swz % 64) / 2; }
__host__ __device__ __forceinline__ int perm32(int rho) { const int n = rho >> 4, i = rho & 15; return 8 * (i >> 2) + 4 * n + (i & 3); }

struct Unit { int pm, pn, ui; };
struct Gemm { const GAS bf16_t* A; const GAS bf16_t* Bt; int M, N, K, lda, acol; };

struct StaticOrder {
    int nM, nN, nwg, G, c;
    __device__ void init(int M, int N, int G_, int c_) { nM = M / BM; nN = N / BM; nwg = nM * nN; G = G_; c = c_; }
    __device__ bool next(int i, Unit& u) const {
        const long L = (long)i * G + c; if (L >= nwg) return false;
        int wgid = (int)L; { const int q = nwg / NXCD, r = nwg % NXCD, xcd = wgid % NXCD, off = wgid / NXCD; wgid = (xcd < r ? xcd * (q + 1) : r * (q + 1) + (xcd - r) * q) + off; }
        const int nig = WGM * nN, gid = wgid / nig, fm = gid * WGM, gsz = (nM - fm) < WGM ? (nM - fm) : WGM;
        u.pm = fm + ((wgid % nig) % gsz); u.pn = (wgid % nig) / gsz; u.ui = i; return true;
    }
};

template <class Epi>
__device__ __forceinline__ void gemm_phase(LAS unsigned char* lds, const Gemm g, const StaticOrder& S, const Epi& E) {
    const bool PERMR = E.perm();
    const int tid = threadIdx.x, wid = __builtin_amdgcn_readfirstlane(tid >> 6), lane = tid & 63, wr = wid >> 2, wc = wid & 3, fr = lane & 15, fq = lane >> 4;
    const int K = g.K, nt = K / BK;
    unsigned voffA[2], voffB[2];
#pragma unroll
    for (int i = 0; i < 2; ++i) { int R, C; stage_rc(tid * 16 + i * 8192, R, C); const int Rb = PERMR ? ((R & ~31) + perm32(R & 31)) : R;
        voffA[i] = (unsigned)(R * g.lda + C) * 2u; voffB[i] = (unsigned)(Rb * K + C) * 2u; }
    const size_t kstep = (size_t)(BK * 2);
    const size_t hstepA = (size_t)HALF * g.lda * 2, hstepB = (size_t)HALF * K * 2;
    const unsigned ldsw = (unsigned)wid * 1024u;
    const int aoff = lds_byte(wr * 64 + fr, fq * 8), boff = lds_byte(wc * 32 + fr, fq * 8);
#define PG8_SA(b, h) (((b) * 2 + (h)) * HTB)
#define PG8_SB(b, h) ((4 + (b) * 2 + (h)) * HTB)
#define PG8_STAGE(bufoff, gbase, voff) do { _Pragma("unroll") for (int _i = 0; _i < 2; ++_i) \
        __builtin_amdgcn_global_load_lds((const unsigned*)((const char*)(gbase) + (voff)[_i]), (LAS unsigned*)(lds + (bufoff) + ldsw + _i * 8192), 16, 0, 0); } while (0)
#define PG8_LDA(dst, b, h) do { _Pragma("unroll") for (int m = 0; m < 4; ++m) _Pragma("unroll") for (int k = 0; k < 2; ++k) dst[m][k] = *(const LAS bf16x8*)(lds + PG8_SA(b, h) + aoff + m * 2048 + k * 1024); } while (0)
#define PG8_LDB(dst, b, h) do { _Pragma("unroll") for (int n = 0; n < 2; ++n) _Pragma("unroll") for (int k = 0; k < 2; ++k) dst[n][k] = *(const LAS bf16x8*)(lds + PG8_SB(b, h) + boff + n * 2048 + k * 1024); } while (0)
#define PG8_MMA(ai, bj, At, Bt) do { __builtin_amdgcn_s_setprio(1); _Pragma("unroll") for (int m = 0; m < 4; ++m) _Pragma("unroll") for (int n = 0; n < 2; ++n) _Pragma("unroll") for (int k = 0; k < 2; ++k) \
        acc[ai][bj][m][n] = __builtin_amdgcn_mfma_f32_16x16x32_bf16(Bt[n][k], At[m][k], acc[ai][bj][m][n], 0, 0, 0); __builtin_amdgcn_s_setprio(0); } while (0)
#define PG8_WAIT_V(n) asm volatile("s_waitcnt vmcnt(" #n ")" ::: "memory")
#define PG8_WAIT_L(n) asm volatile("s_waitcnt lgkmcnt(" #n ")" ::: "memory")
#define PG8_BAR __builtin_amdgcn_s_barrier()
#define PG8_SCHED __builtin_amdgcn_sched_barrier(0)
    Unit cur, nxt; int ui = 0;
    if (!S.next(0, cur)) return;
    f32x4 acc[2][2][4][2];
#pragma unroll
    for (int a = 0; a < 2; ++a)
#pragma unroll
        for (int b = 0; b < 2; ++b)
#pragma unroll
            for (int m = 0; m < 4; ++m)
#pragma unroll
                for (int n = 0; n < 2; ++n) acc[a][b][m][n] = (f32x4){0.f, 0.f, 0.f, 0.f};
    bf16x8 At[4][2], B0[2][2], B1[2][2];
    const char* cA = (const char*)g.A + (size_t)cur.pm * 2 * hstepA + (size_t)cur.pn * g.acol * 2;
    const char* cB = (const char*)g.Bt + (size_t)cur.pn * 2 * hstepB;
    PG8_STAGE(PG8_SB(0, 0), cB, voffB); PG8_STAGE(PG8_SB(0, 1), cB + hstepB, voffB); PG8_STAGE(PG8_SA(0, 0), cA, voffA); PG8_STAGE(PG8_SA(0, 1), cA + hstepA, voffA);
    if (wr == 1) PG8_BAR;
    PG8_WAIT_V(2); PG8_BAR;
    PG8_STAGE(PG8_SB(1, 0), cB + kstep, voffB); PG8_STAGE(PG8_SA(1, 0), cA + kstep, voffA); PG8_STAGE(PG8_SB(1, 1), cB + hstepB + kstep, voffB);
    PG8_WAIT_V(6); PG8_BAR;
    for (;;) {
        const bool has_next = S.next(ui + 1, nxt);
        const char* nA = has_next ? (const char*)g.A + (size_t)nxt.pm * 2 * hstepA + (size_t)nxt.pn * g.acol * 2 : cA;
        const char* nB = has_next ? (const char*)g.Bt + (size_t)nxt.pn * 2 * hstepB : cB;
        for (int t = 0; t < nt; t += 2) {
            const bool last = (t == nt - 2);
            const char* a1 = cA + (size_t)(t + 1) * kstep;
            const char* a2 = last ? nA : cA + (size_t)(t + 2) * kstep; const char* b2 = last ? nB : cB + (size_t)(t + 2) * kstep;
            const char* a3 = a2 + kstep; const char* b3 = b2 + kstep;
            PG8_LDB(B0, 0, 0); PG8_LDB(B1, 0, 1); PG8_SCHED; PG8_LDA(At, 0, 0); PG8_STAGE(PG8_SA(1, 1), a1 + hstepA, voffA);
            PG8_WAIT_V(8); PG8_WAIT_L(0); PG8_BAR; PG8_MMA(0, 0, At, B0); PG8_MMA(0, 1, At, B1); PG8_BAR; PG8_SCHED;
            PG8_LDA(At, 0, 1); PG8_STAGE(PG8_SB(0, 0), b2, voffB); PG8_STAGE(PG8_SB(0, 1), b2 + hstepB, voffB); PG8_STAGE(PG8_SA(0, 0), a2, voffA);
            PG8_WAIT_V(8); PG8_WAIT_L(0); PG8_BAR; PG8_MMA(1, 0, At, B0); PG8_MMA(1, 1, At, B1); PG8_BAR; PG8_SCHED;
            PG8_LDB(B0, 1, 0); PG8_LDB(B1, 1, 1); PG8_SCHED; PG8_LDA(At, 1, 0); PG8_STAGE(PG8_SA(0, 1), a2 + hstepA, voffA);
            PG8_WAIT_V(8); PG8_WAIT_L(0); PG8_BAR; PG8_MMA(0, 0, At, B0); PG8_MMA(0, 1, At, B1); PG8_BAR; PG8_SCHED;
            PG8_LDA(At, 1, 1); PG8_STAGE(PG8_SB(1, 0), b3, voffB); PG8_STAGE(PG8_SB(1, 1), b3 + hstepB, voffB); PG8_STAGE(PG8_SA(1, 0), a3, voffA);
            PG8_WAIT_V(8); PG8_WAIT_L(0); PG8_BAR; PG8_MMA(1, 0, At, B0); PG8_MMA(1, 1, At, B1); PG8_BAR; PG8_SCHED;
        }
        if (wr == 0) PG8_BAR;
        E(acc, cur, wr, wc, fr, fq);
        if (!has_next) break;
#pragma unroll
        for (int a = 0; a < 2; ++a)
#pragma unroll
            for (int b = 0; b < 2; ++b)
#pragma unroll
                for (int m = 0; m < 4; ++m)
#pragma unroll
                    for (int n = 0; n < 2; ++n) acc[a][b][m][n] = (f32x4){0.f, 0.f, 0.f, 0.f};
        cur = nxt; cA = nA; cB = nB; ++ui;
        if (wr == 1) PG8_BAR;
    }
    PG8_WAIT_V(0);
    PG8_BAR;
#undef PG8_SA
#undef PG8_SB
#undef PG8_STAGE
#undef PG8_LDA
#undef PG8_LDB
#undef PG8_MMA
#undef PG8_WAIT_V
#undef PG8_WAIT_L
#undef PG8_BAR
#undef PG8_SCHED
}
}
using pg8::Unit;

__device__ __forceinline__ float row_rs(const GAS float* ssq, int row, int fq) {
    const f32x4 v = *(const GAS f32x4*)(ssq + (size_t)row * 16 + fq * 4);
    float s = (v[0] + v[1]) + (v[2] + v[3]);
    s += __shfl_xor(s, 16); s += __shfl_xor(s, 32);
    return rsqrtf(s * (1.0f / D) + RMS_EPS);
}
__device__ __forceinline__ float silu_mul(float g, float u) { const float e = __builtin_amdgcn_exp2f(-g * 1.4426950408889634f); return g * __builtin_amdgcn_rcpf(1.0f + e) * u; }

constexpr int TAB_OFF_C = 131072;
struct EpiAll {
    int kind;
    GAS void* p0; GAS void* p1; GAS float* ssq; const GAS float* rope; GAS float* out; float alpha;
    LAS unsigned char* ldsb;
    __device__ __forceinline__ bool perm() const { return kind < 3 || kind == 5; }
    template <int NAI, int NM>
    __device__ __forceinline__ void swiglu(const f32x4 (&acc)[2][2][4][2], const Unit& u, int wr, int wc, int fr, int fq) const {
        GAS bf16_t* O = (GAS bf16_t*)p0;
        const int row0 = u.pm * 256 + wr * 64 + fr, col0 = u.pn * 128 + wc * 32 + 8 * fq;
        f32x4 cpv[6]; GAS f32x4* cpd[6];
        if (NAI == 2) {
            constexpr unsigned per_b = (unsigned)(WMAX - 1) * D / 4, full_b = (unsigned)WMAX * D / 4, tot = 2u * NS * per_b;
            const LAS unsigned* t = (const LAS unsigned*)(ldsb + TAB_OFF_C);
            const unsigned long long pk = ((unsigned long long)(unsigned)__builtin_amdgcn_readfirstlane(t[7]) << 32) | (unsigned long long)(unsigned)__builtin_amdgcn_readfirstlane(t[6]);
            const unsigned long long pv = ((unsigned long long)(unsigned)__builtin_amdgcn_readfirstlane(t[9]) << 32) | (unsigned long long)(unsigned)__builtin_amdgcn_readfirstlane(t[8]);
            const GAS f32x4* sk = (const GAS f32x4*)pk; const GAS f32x4* sv = (const GAS f32x4*)pv;
            GAS f32x4* dk = (GAS f32x4*)(out + O_CKS); GAS f32x4* dv = (GAS f32x4*)(out + O_CVS);
            const unsigned Gn = gridDim.x, upw = (128u * 22u + Gn - 1u) / Gn;
            const unsigned chunk = ((unsigned)alpha * upw + (unsigned)u.ui) * Gn + blockIdx.x;
#pragma unroll
            for (int k = 0; k < 6; ++k) { unsigned j = chunk * 3072u + threadIdx.x + 512u * (unsigned)k; const bool ok = j < tot; j = ok ? j : 0u;
                const unsigned ck = j / per_b, r = j - ck * per_b, b = ck >> 1;
                cpv[k] = __builtin_nontemporal_load(((ck & 1) ? sv : sk) + (size_t)b * full_b + (D / 4) + r);
                cpd[k] = ok ? ((ck & 1) ? dv : dk) + (size_t)b * full_b + r : (GAS f32x4*)nullptr; }
        }
#pragma unroll
        for (int ai = 0; ai < NAI; ++ai)
#pragma unroll
            for (int m = 0; m < NM; ++m) {
                const int row = row0 + ai * 128 + m * 16; const float r = row_rs(ssq, row, fq);
                const float r2 = r * r, cneg = r * -1.4426950408889634f;
                float o[8];
#pragma unroll
                for (int n = 0; n < 2; ++n)
#pragma unroll
                    for (int e = 0; e < 4; ++e) { const float g = acc[ai][0][m][n][e], uu = acc[ai][1][m][n][e];
                        o[n * 4 + e] = (g * uu) * r2 * __builtin_amdgcn_rcpf(1.0f + __builtin_amdgcn_exp2f(g * cneg)); }
                u32x4 w; w.x = cvt_pk_bf16(o[0], o[1]); w.y = cvt_pk_bf16(o[2], o[3]); w.z = cvt_pk_bf16(o[4], o[5]); w.w = cvt_pk_bf16(o[6], o[7]);
                *(GAS u32x4*)(O + (size_t)row * FF + col0) = w;
            }
        if (NAI == 2) {
#pragma unroll
            for (int k = 0; k < 6; ++k) if (cpd[k]) __builtin_nontemporal_store(cpv[k], cpd[k]);
        }
    }
    template <bool FINAL, int NAI, int NM>
    __device__ __forceinline__ void res(const f32x4 (&acc)[2][2][4][2], const Unit& u, int wr, int wc, int fr, int fq) const {
        GAS float* X = (GAS float*)p0; GAS bf16_t* XB = (GAS bf16_t*)p1;
        const int row0 = u.pm * 256 + wr * 64 + fr, col0 = u.pn * 256 + wc * 32 + 8 * fq;
#pragma unroll
        for (int ai = 0; ai < NAI; ++ai)
#pragma unroll
            for (int m = 0; m < NM; ++m) {
                const int row = row0 + ai * 128 + m * 16; float ss = 0.f;
#pragma unroll
                for (int bj = 0; bj < 2; ++bj) {
                    GAS bf16_t* px = XB + (size_t)row * D + col0 + bj * 128;
                    const u32x4 ob = *(const GAS u32x4*)px;
                    const f32x4 b0 = (f32x4){__uint_as_float(ob.x << 16), __uint_as_float(ob.x & 0xffff0000u), __uint_as_float(ob.y << 16), __uint_as_float(ob.y & 0xffff0000u)};
                    const f32x4 b1 = (f32x4){__uint_as_float(ob.z << 16), __uint_as_float(ob.z & 0xffff0000u), __uint_as_float(ob.w << 16), __uint_as_float(ob.w & 0xffff0000u)};
                    const f32x4 v0 = b0 + acc[ai][bj][m][0] * alpha, v1 = b1 + acc[ai][bj][m][1] * alpha;
                    ss += (v0[0] * v0[0] + v0[1] * v0[1]) + (v0[2] * v0[2] + v0[3] * v0[3]) + (v1[0] * v1[0] + v1[1] * v1[1]) + (v1[2] * v1[2] + v1[3] * v1[3]);
                    if (FINAL) { GAS float* pf = X + (size_t)row * D + col0 + bj * 128; *(GAS f32x4*)pf = v0; *(GAS f32x4*)(pf + 4) = v1; }
                    else { u32x4 w; w.x = cvt_pk_bf16(v0[0], v0[1]); w.y = cvt_pk_bf16(v0[2], v0[3]); w.z = cvt_pk_bf16(v1[0], v1[1]); w.w = cvt_pk_bf16(v1[2], v1[3]); *(GAS u32x4*)px = w; }
                }
                ss += __shfl_xor(ss, 16); ss += __shfl_xor(ss, 32);
                if (fq == 0) ssq[(size_t)row * 16 + u.pn * 4 + wc] = ss;
            }
    }
    template <int NAI, int NM>
    __device__ __forceinline__ void store(const f32x4 (&acc)[2][2][4][2], const Unit& u, int wr, int wc, int fr, int fq) const {
        GAS bf16_t* O = (GAS bf16_t*)p0;
        const int row0 = u.pm * 256 + wr * 64 + fr, col0 = u.pn * 256 + wc * 32 + 8 * fq;
#pragma unroll
        for (int ai = 0; ai < NAI; ++ai)
#pragma unroll
            for (int m = 0; m < NM; ++m) {
                const int row = row0 + ai * 128 + m * 16;
#pragma unroll
                for (int bj = 0; bj < 2; ++bj) {
                    const f32x4 v0 = acc[ai][bj][m][0], v1 = acc[ai][bj][m][1];
                    u32x4 w; w.x = cvt_pk_bf16(v0[0], v0[1]); w.y = cvt_pk_bf16(v0[2], v0[3]); w.z = cvt_pk_bf16(v1[0], v1[1]); w.w = cvt_pk_bf16(v1[2], v1[3]);
                    *(GAS u32x4*)(O + (size_t)row * D + col0 + bj * 128) = w;
                }
            }
    }
    template <bool ISQ, int NAI, int NM>
    __device__ __forceinline__ void kvq(const f32x4 (&acc)[2][2][4][2], const Unit& u, int wr, int wc, int fr, int fq) const {
        const int row0 = u.pm * 256 + wr * 64 + fr;
        const bool isK = ISQ || u.pn < 4;
        const int colb = (ISQ ? u.pn : (u.pn & 3)) * 256 + wc * 32 + 4 * fq;
        GAS bf16_t* dstb = (GAS bf16_t*)((ISQ || isK) ? p0 : p1);
        const int ldo = ISQ ? NQ : D;
        const bool dorope = isK && wc == 0;
#pragma unroll
        for (int ai = 0; ai < NAI; ++ai)
#pragma unroll
            for (int m = 0; m < NM; ++m) {
                const int row = row0 + ai * 128 + m * 16; const float r = row_rs(ssq, row, fq) * (ISQ ? QSCALE : 1.0f);
                const bool prompt = row < MP;
                const int t = row & (SEQ - 1), b = row >> 13, sb = row - MP;
                const int pidx = prompt ? t : SEQ;
                GAS float* fdst = nullptr;
                if (!ISQ) {
                    if (prompt) { if (t >= SEQ - WMAX) fdst = out + (isK ? O_CKP : O_CVP) + ((size_t)b * WMAX + (t - (SEQ - WMAX))) * D; }
                    else if (sb < NS) fdst = out + (isK ? O_CKS : O_CVS) + ((size_t)sb * WMAX + (WMAX - 1)) * D;
                }
                f32x4 cs = (f32x4){1.f, 1.f, 1.f, 1.f}, sn = (f32x4){0.f, 0.f, 0.f, 0.f};
                if (dorope) { cs = *(const GAS f32x4*)(rope + (size_t)pidx * 32 + 4 * fq); sn = *(const GAS f32x4*)(rope + (size_t)pidx * 32 + 16 + 4 * fq); }
#pragma unroll
                for (int bj = 0; bj < 2; ++bj) {
                    f32x4 v0 = acc[ai][bj][m][0] * r, v1 = acc[ai][bj][m][1] * r;
                    if (dorope) { const f32x4 r1 = v0 * cs - v1 * sn, r2 = v1 * cs + v0 * sn; v0 = r1; v1 = r2; }
                    const int c = colb + bj * 128;
                    u32x2 w0, w1; w0.x = cvt_pk_bf16(v0[0], v0[1]); w0.y = cvt_pk_bf16(v0[2], v0[3]); w1.x = cvt_pk_bf16(v1[0], v1[1]); w1.y = cvt_pk_bf16(v1[2], v1[3]);
                    *(GAS u32x2*)(dstb + (size_t)row * ldo + c) = w0; *(GAS u32x2*)(dstb + (size_t)row * ldo + c + 16) = w1;
                    if (!ISQ) { if (fdst) { *(GAS f32x4*)(fdst + c) = v0; *(GAS f32x4*)(fdst + c + 16) = v1; } }
                }
            }
    }
    template <int NAI, int NM>
    __device__ __forceinline__ void run(const f32x4 (&acc)[2][2][4][2], const Unit& u, int wr, int wc, int fr, int fq) const {
        if (kind == 0) swiglu<NAI, NM>(acc, u, wr, wc, fr, fq);
        else if (kind == 1) res<false, NAI, NM>(acc, u, wr, wc, fr, fq);
        else if (kind == 5) res<true, NAI, NM>(acc, u, wr, wc, fr, fq);
        else if (kind == 2) store<NAI, NM>(acc, u, wr, wc, fr, fq);
        else if (kind == 3) kvq<false, NAI, NM>(acc, u, wr, wc, fr, fq);
        else kvq<true, NAI, NM>(acc, u, wr, wc, fr, fq);
    }
    __device__ __forceinline__ void operator()(const f32x4 (&acc)[2][2][4][2], const Unit& u, int wr, int wc, int fr, int fq) const { run<2, 4>(acc, u, wr, wc, fr, fq); }
};

__device__ __forceinline__ void skinny_item(LAS unsigned char* lds, const pg8::Gemm g, const EpiAll& E, int item) {
    int t_ = threadIdx.x; asm volatile("" : "+v"(t_));
    const int tid = t_, lane = tid & 63, wave = __builtin_amdgcn_readfirstlane(tid >> 6), fr = lane & 15, fq = lane >> 4;
    const int pn = item >> 2, wc = item & 3, K = g.K, ksp = K >> 3, steps = ksp >> 5;
    const bool perm = E.perm();
    const GAS bf16_t* ap[2]; const GAS bf16_t* bp[2][2];
#pragma unroll
    for (int m = 0; m < 2; ++m) ap[m] = g.A + (size_t)(MP + 16 * m + fr) * g.lda + (size_t)pn * g.acol + wave * ksp + 8 * fq;
#pragma unroll
    for (int bj = 0; bj < 2; ++bj)
#pragma unroll
        for (int n = 0; n < 2; ++n) { const int rloc = perm ? (8 * (fr >> 2) + 4 * n + (fr & 3)) : (16 * n + fr);
            bp[bj][n] = g.Bt + (size_t)(256 * pn + 128 * bj + 32 * wc + rloc) * K + wave * ksp + 8 * fq; }
    f32x4 acc[2][2][4][2];
#pragma unroll
    for (int bj = 0; bj < 2; ++bj)
#pragma unroll
        for (int m = 0; m < 2; ++m)
#pragma unroll
            for (int n = 0; n < 2; ++n) acc[0][bj][m][n] = (f32x4){0.f, 0.f, 0.f, 0.f};
#pragma unroll 4
    for (int s = 0; s < steps; ++s) {
        bf16x8 a[2], b[2][2];
#pragma unroll
        for (int m = 0; m < 2; ++m) a[m] = *(const GAS bf16x8*)(ap[m] + 32 * s);
#pragma unroll
        for (int bj = 0; bj < 2; ++bj)
#pragma unroll
            for (int n = 0; n < 2; ++n) b[bj][n] = *(const GAS bf16x8*)(bp[bj][n] + 32 * s);
#pragma unroll
        for (int bj = 0; bj < 2; ++bj)
#pragma unroll
            for (int m = 0; m < 2; ++m)
#pragma unroll
                for (int n = 0; n < 2; ++n) acc[0][bj][m][n] = __builtin_amdgcn_mfma_f32_16x16x32_bf16(b[bj][n], a[m], acc[0][bj][m][n], 0, 0, 0);
    }
    LAS f32x4* red = (LAS f32x4*)lds;
#pragma unroll
    for (int bj = 0; bj < 2; ++bj)
#pragma unroll
        for (int m = 0; m < 2; ++m)
#pragma unroll
            for (int n = 0; n < 2; ++n) red[(wave * 8 + (bj * 4 + m * 2 + n)) * 64 + lane] = acc[0][bj][m][n];
    __syncthreads();
    if (wave == 0) {
#pragma unroll
        for (int bj = 0; bj < 2; ++bj)
#pragma unroll
            for (int m = 0; m < 2; ++m)
#pragma unroll
                for (int n = 0; n < 2; ++n) { f32x4 s = red[(bj * 4 + m * 2 + n) * 64 + lane];
#pragma unroll
                    for (int w = 1; w < 8; ++w) s += red[(w * 8 + (bj * 4 + m * 2 + n)) * 64 + lane];
                    acc[0][bj][m][n] = s; }
        Unit u; u.pm = MP / 256; u.pn = pn; u.ui = 0;
        E.run<1, 2>(acc, u, 0, wc, fr, fq);
    }
    __syncthreads();
}
__device__ __forceinline__ void transpose_item(const float* W, int K, int N, bf16_t* WT, int dst_row0, int k0, int n0, LAS float* scr, int lane, const float* kgain, const float* ngain) {
    { f32x4 v[8];
#pragma unroll
      for (int i = 0; i < 8; ++i) { const int kk = 8 * i + (lane >> 3); v[i] = *(const GAS f32x4*)(W + (size_t)(k0 + kk) * N + n0 + 4 * (lane & 7)); }
#pragma unroll
      for (int i = 0; i < 8; ++i) { const int kk = 8 * i + (lane >> 3); const float kg = kgain ? kgain[k0 + kk] : 1.0f; LAS float* d = scr + kk * 33 + 4 * (lane & 7);
          d[0] = v[i][0] * kg; d[1] = v[i][1] * kg; d[2] = v[i][2] * kg; d[3] = v[i][3] * kg; } }
    asm volatile("s_waitcnt lgkmcnt(0)" ::: "memory");
    const int c = lane & 7;
#pragma unroll
    for (int j = 0; j < 4; ++j) { const int n = (lane >> 3) + 8 * j; const LAS float* s = scr + (8 * c) * 33 + n; const float ng = ngain ? ngain[n0 + n] : 1.0f;
        u32x4 o; o.x = cvt_pk_bf16(s[0 * 33] * ng, s[1 * 33] * ng); o.y = cvt_pk_bf16(s[2 * 33] * ng, s[3 * 33] * ng); o.z = cvt_pk_bf16(s[4 * 33] * ng, s[5 * 33] * ng); o.w = cvt_pk_bf16(s[6 * 33] * ng, s[7 * 33] * ng);
        *(GAS u32x4*)(WT + (size_t)(dst_row0 + n) * K + k0 + 8 * c) = o; }
    asm volatile("s_waitcnt lgkmcnt(0)" ::: "memory");
}
__device__ __forceinline__ void transpose_matrix(const float* W, int K, int N, bf16_t* WT, int mode, const float* kgain, const float* ngain, LAS float* scr, int gw, int NGW, int lane) {
    const int nblk = N / 32, items = (K / 64) * nblk;
    for (int it = gw; it < items; it += NGW) {
        const int kb = it / nblk, nb = it % nblk, k0 = 64 * kb, n0 = 32 * nb;
        int dr = n0;
        if (mode == 1) { if (n0 < FF) dr = 256 * (n0 / 128) + (n0 % 128); else { const int f = n0 - FF; dr = 256 * (f / 128) + 128 + (f % 128); } }
        transpose_item(W, K, N, WT, dr, k0, n0, scr, lane, kgain, ngain);
    }
}
__device__ __forceinline__ void sincos_d(double x, double& s, double& c) {
    const double kq = rint(x * 0.63661977236758134308);
    double r = fma(-kq, 1.57079632679489655800e+00, x); r = fma(-kq, 6.12323399573676603587e-17, r);
    const double r2 = r * r;
    const double sp = r * (1.0 + r2 * (-1.0 / 6 + r2 * (1.0 / 120 + r2 * (-1.0 / 5040 + r2 * (1.0 / 362880 + r2 * (-1.0 / 39916800 + r2 * (1.0 / 6227020800.0 + r2 * (-1.0 / 1307674368000.0))))))));
    const double cp = 1.0 + r2 * (-0.5 + r2 * (1.0 / 24 + r2 * (-1.0 / 720 + r2 * (1.0 / 40320 + r2 * (-1.0 / 3628800 + r2 * (1.0 / 479001600.0 + r2 * (-1.0 / 87178291200.0 + r2 * (1.0 / 20922789888000.0))))))));
    const int q = (int)((long long)kq & 3);
    s = (q == 0) ? sp : (q == 1) ? cp : (q == 2) ? -sp : -cp;
    c = (q == 0) ? cp : (q == 1) ? -sp : (q == 2) ? -cp : sp;
}

__device__ __forceinline__ int kv_off(int row, int ch) { return 256 * row + 16 * (ch ^ (((row & 3) << 2) | ((row >> 2) & 3))); }

#define XB_TMO      128
#define XB_XCNT(j)  (256  + 64 * (j))
#define XB_XSUB(j)  (1280 + 64 * (j))
#define XB_XGEN(j)  (2304 + 64 * (j))
#define XB_TOP      3328
#define XB_TOPGEN   3392
#define XCD_BAR_WORDS 3456
#define XB_SPIN_CAP (1u << 18)

__device__ __forceinline__ unsigned xb_ld(unsigned* p)              { return __hip_atomic_load(p, __ATOMIC_RELAXED, __HIP_MEMORY_SCOPE_AGENT); }
__device__ __forceinline__ unsigned xb_add(unsigned* p, unsigned v) { return __hip_atomic_fetch_add(p, v, __ATOMIC_RELAXED, __HIP_MEMORY_SCOPE_AGENT); }
__device__ __forceinline__ unsigned xb_xcc_id() { return (unsigned)__builtin_amdgcn_s_getreg((3 << 11) | 20) & 0xFu; }
#define XB_SPIN(cond, bar) do { unsigned _sp = 0; while (cond) { __builtin_amdgcn_s_sleep(1); \
    if ((++_sp & 255u) == 0u) { if (xb_ld(&(bar)[XB_TMO])) break; if (_sp > XB_SPIN_CAP) { atomicAdd(&(bar)[XB_TMO], 1u); break; } } } } while (0)

struct XcdBarrier {
    unsigned* bar; unsigned x;
    volatile LAS unsigned* st;
};

__device__ __forceinline__ XcdBarrier xcd_barrier_post(unsigned* bar, volatile LAS unsigned* st) {
    XcdBarrier b; b.bar = bar; b.x = xb_xcc_id(); b.st = st;
    if (threadIdx.x == 0) (void)xb_add(&bar[XB_XCNT(b.x)], 1u);
    return b;
}
__device__ __forceinline__ void xcd_barrier_complete(unsigned* bar, unsigned x, unsigned& nloc, unsigned& nx) {
    const unsigned G = gridDim.x * gridDim.y * gridDim.z;
    unsigned sum, cnt, mine, sp = 0u;
    for (;;) {
        sum = 0u; cnt = 0u; mine = 0u;
#pragma unroll
        for (unsigned j = 0; j < 16; ++j) { const unsigned c = xb_ld(&bar[XB_XCNT(j)]); sum += c; cnt += (c > 0u) ? 1u : 0u; mine = (j == x) ? c : mine; }
        if (sum == G) break;
        __builtin_amdgcn_s_sleep(1);
        if ((++sp & 255u) == 0u) { if (xb_ld(&bar[XB_TMO])) break; if (sp > XB_SPIN_CAP) { atomicAdd(&bar[XB_TMO], 1u); break; } }
    }
    nloc = mine > 0u ? mine : 1u; nx = cnt > 0u ? cnt : 1u;
}

__device__ __forceinline__ void xcd_barrier(const XcdBarrier& b) {
    asm volatile("s_waitcnt vmcnt(0)" ::: "memory");
    __syncthreads();
    if (threadIdx.x == 0) {
        unsigned* bar = b.bar;
        __builtin_amdgcn_s_waitcnt(0);
        unsigned nloc = b.st[0], nx = b.st[1];
        if (nloc == 0u) { xcd_barrier_complete(bar, b.x, nloc, nx); b.st[0] = nloc; b.st[1] = nx; }
        const unsigned old = xb_add(&bar[XB_XSUB(b.x)], 1u);
        const unsigned gen = old / nloc;
        if (old + 1u == (gen + 1u) * nloc) {
            __builtin_amdgcn_fence(__ATOMIC_RELEASE, "agent");
            asm volatile("s_waitcnt vmcnt(0)" ::: "memory");
            const unsigned og = xb_add(&bar[XB_TOP], 1u);
            const unsigned tg = og / nx;
            if (og + 1u == (tg + 1u) * nx) xb_add(&bar[XB_TOPGEN], 1u);
            else XB_SPIN(xb_ld(&bar[XB_TOPGEN]) == tg, bar);
            __builtin_amdgcn_fence(__ATOMIC_ACQUIRE, "agent");
            xb_add(&bar[XB_XGEN(b.x)], 1u);
            asm volatile("s_waitcnt vmcnt(0)" ::: "memory");
        } else {
            XB_SPIN(xb_ld(&bar[XB_XGEN(b.x)]) == gen, bar);
            __builtin_amdgcn_fence(__ATOMIC_ACQUIRE, "agent");
            asm volatile("s_waitcnt vmcnt(0)" ::: "memory");
        }
    }
    __syncthreads();
}

constexpr int TAB_OFF = 131072;
struct GD { unsigned long long A, Bt, p0, p1; int N, K, lda, acol, kind, sync; float alpha; int pad; };
constexpr int NGEMM = 13;
__device__ __forceinline__ GAS unsigned char* ldp(LAS unsigned char* lds, int i) {
    const LAS unsigned* t = (const LAS unsigned*)(lds + TAB_OFF) + 2 * i;
    const unsigned lo = __builtin_amdgcn_readfirstlane(t[0]), hi = __builtin_amdgcn_readfirstlane(t[1]);
    return (GAS unsigned char*)(((unsigned long long)hi << 32) | lo);
}

#define XBAR_ST_OFF (TAB_OFF + 2048)
#define GRID_BAR() do { XcdBarrier b_; b_.bar = (unsigned*)ldp(lds, 21); b_.x = xb_xcc_id(); b_.st = (volatile LAS unsigned*)(lds + XBAR_ST_OFF); xcd_barrier(b_); } while (0)
__global__ void __launch_bounds__(512, 2) yoco_fwd(Params P) {
    extern __shared__ __attribute__((aligned(16))) unsigned char lds_raw[];
    LAS unsigned char* lds = (LAS unsigned char*)lds_raw;
    cg::grid_group grid = cg::this_grid();
    const int tid = threadIdx.x, lane = tid & 63, wave = __builtin_amdgcn_readfirstlane(tid >> 6);
    const int G = gridDim.x, bx = blockIdx.x;
    const size_t WIN_E = (size_t)2 * FF * D, WOUT_E = (size_t)D * FF;

    if (tid == 0) { ((volatile LAS unsigned*)(lds + XBAR_ST_OFF))[0] = 0u; ((volatile LAS unsigned*)(lds + XBAR_ST_OFF))[1] = 0u; }
    (void)xcd_barrier_post((unsigned*)P.ws, (volatile LAS unsigned*)(lds + XBAR_ST_OFF));
    if (tid == 0) {
        LAS unsigned long long* pt = (LAS unsigned long long*)(lds + TAB_OFF);
#define PT(i) pt[i] = (unsigned long long)P.in[i]
        PT(0); PT(1); PT(2); PT(3); PT(4); PT(5); PT(6); PT(7); PT(8); PT(9); PT(10); PT(11); PT(12); PT(13); PT(14); PT(15); PT(16); PT(17); PT(18); PT(19);
#undef PT
        pt[20] = (unsigned long long)P.out; pt[21] = (unsigned long long)P.ws;
        const unsigned long long w = (unsigned long long)P.ws;
        LAS GD* gd = (LAS GD*)(lds + TAB_OFF + 256);
        const unsigned long long XBp = w + WS_XB, ACTp = w + WS_ACT, XFp = w + WS_XF, PBp = w + WS_PB, ZBp = w + WS_ZB;
#define SETG(i, A_, B_, P0_, P1_, N_, K_, LDA_, AC_, KIND_, SYNC_, AL_) do { LAS unsigned long long* q_ = (LAS unsigned long long*)(gd + (i)); q_[0] = (A_); q_[1] = (B_); q_[2] = (P0_); q_[3] = (P1_); LAS int* r_ = (LAS int*)(q_ + 4); r_[0] = (N_); r_[1] = (K_); r_[2] = (LDA_); r_[3] = (AC_); r_[4] = (KIND_); r_[5] = (SYNC_); ((LAS float*)r_)[6] = (AL_); r_[7] = 0; } while (0)
        SETG(0, XBp, w + WS_WIN, ACTp, 0ull, 2 * FF, D, D, 0, 0, 1, 0.f);
        SETG(1, ACTp, w + WS_WOUT, XFp, XBp, D, FF, FF, 0, 1, 1, 0.5f);
        SETG(2, PBp, w + WS_WPG, ZBp, 0ull, D, 256, D, 256, 2, 1, 0.f);
        SETG(3, ZBp, w + WS_WPO, XFp, XBp, D, D, D, 0, 1, 1, 1.0f);
        SETG(4, XBp, w + WS_WIN + WIN_BYTES, ACTp, 0ull, 2 * FF, D, D, 0, 0, 1, 1.f);
        SETG(5, ACTp, w + WS_WOUT + WOUT_BYTES, XFp, XBp, D, FF, FF, 0, 1, 1, 0.5f);
        SETG(6, XBp, w + WS_WKV, w + WS_KB, w + WS_VB, 2 * D, D, D, 0, 3, 0, 0.f);
        SETG(7, XBp, w + WS_WIN + 2 * WIN_BYTES, ACTp, 0ull, 2 * FF, D, D, 0, 0, 1, 2.f);
        SETG(8, ACTp, w + WS_WOUT + 2 * WOUT_BYTES, XFp, XBp, D, FF, FF, 0, 1, 1, 0.5f);
        SETG(9, XBp, w + WS_WQ, w + WS_QB, 0ull, NQ, D, D, 0, 4, 1, 0.f);
        SETG(10, PBp, w + WS_WO, XFp, XBp, D, D, D, 0, 1, 1, 1.0f);
        SETG(11, XBp, w + WS_WIN + 3 * WIN_BYTES, ACTp, 0ull, 2 * FF, D, D, 0, 0, 1, 3.f);
        SETG(12, ACTp, w + WS_WOUT + 3 * WOUT_BYTES, XFp, XBp, D, FF, FF, 0, 1, 1, 0.5f);
#undef SETG
    }
    __syncthreads();

    {
        const int gw = bx * 8 + wave, NGW = G * 8;
        const size_t gtid = (size_t)bx * 512 + tid, GT = (size_t)G * 512;
        GAS unsigned char* ws = (GAS unsigned char*)P.ws;
        GAS bf16_t* Win = (GAS bf16_t*)(ws + WS_WIN); GAS bf16_t* Wout = (GAS bf16_t*)(ws + WS_WOUT); GAS bf16_t* Wpg = (GAS bf16_t*)(ws + WS_WPG);
        LAS float* scr = (LAS float*)(lds + wave * 16384);
        transpose_matrix(P.in[6], D, 2 * FF, Win, 1, P.in[5], nullptr, scr, gw, NGW, lane);
        transpose_matrix(P.in[10], D, 2 * FF, Win + WIN_E, 1, P.in[9], nullptr, scr, gw, NGW, lane);
        transpose_matrix(P.in[6] + WIN_E, D, 2 * FF, Win + 2 * WIN_E, 1, P.in[5] + D, nullptr, scr, gw, NGW, lane);
        transpose_matrix(P.in[10] + WIN_E, D, 2 * FF, Win + 3 * WIN_E, 1, P.in[9] + D, nullptr, scr, gw, NGW, lane);
        transpose_matrix(P.in[7], FF, D, Wout, 0, nullptr, nullptr, scr, gw, NGW, lane);
        transpose_matrix(P.in[11], FF, D, Wout + WOUT_E, 0, nullptr, nullptr, scr, gw, NGW, lane);
        transpose_matrix(P.in[7] + WOUT_E, FF, D, Wout + 2 * WOUT_E, 0, nullptr, nullptr, scr, gw, NGW, lane);
        transpose_matrix(P.in[11] + WOUT_E, FF, D, Wout + 3 * WOUT_E, 0, nullptr, nullptr, scr, gw, NGW, lane);
        for (int gi = 0; gi < 4; ++gi) transpose_matrix(P.in[12] + (size_t)gi * 65536, 256, 256, Wpg + (size_t)gi * 65536, 0, nullptr, P.in[13] + gi * 256, scr, gw, NGW, lane);
        transpose_matrix(P.in[14], D, D, (GAS bf16_t*)(ws + WS_WPO), 0, nullptr, nullptr, scr, gw, NGW, lane);
        transpose_matrix(P.in[16], D, 2 * D, (GAS bf16_t*)(ws + WS_WKV), 0, P.in[15], nullptr, scr, gw, NGW, lane);
        transpose_matrix(P.in[17], D, NQ, (GAS bf16_t*)(ws + WS_WQ), 0, P.in[8] + D, nullptr, scr, gw, NGW, lane);
        transpose_matrix(P.in[18], D, D, (GAS bf16_t*)(ws + WS_WO), 0, nullptr, nullptr, scr, gw, NGW, lane);
        {
            const GAS float* x_prompt = (const GAS float*)P.in[0]; const GAS float* x_sample = (const GAS float*)P.in[1];
            GAS bf16_t* XB = (GAS bf16_t*)(ws + WS_XB); GAS float* ssq = (GAS float*)(ws + WS_SSQ);
            for (int row = gw; row < MV; row += NGW) {
                f32x4 v[4];
                if (row < MV) { const f32x4* xr = (const GAS f32x4*)(row < MP ? x_prompt + (size_t)row * D : x_sample + (size_t)(row - MP) * D) + lane;
#pragma unroll
                    for (int j = 0; j < 4; ++j) v[j] = xr[64 * j]; }
                else {
#pragma unroll
                    for (int j = 0; j < 4; ++j) v[j] = (f32x4){0.f, 0.f, 0.f, 0.f}; }
                float s = 0.f;
#pragma unroll
                for (int j = 0; j < 4; ++j) s += (v[j][0] * v[j][0] + v[j][1] * v[j][1]) + (v[j][2] * v[j][2] + v[j][3] * v[j][3]);
                s = wave_sum(s);
                u32x2* bo = (GAS u32x2*)(XB + (size_t)row * D) + lane;
#pragma unroll
                for (int j = 0; j < 4; ++j) { u32x2 w; w.x = cvt_pk_bf16(v[j][0], v[j][1]); w.y = cvt_pk_bf16(v[j][2], v[j][3]); bo[64 * j] = w; }
                if (lane < 16) ssq[(size_t)row * 16 + lane] = lane == 0 ? s : 0.f;
            }
        }
        {
            GAS float* rope = (GAS float*)(ws + WS_ROPE);
            for (size_t i = gtid; i < (size_t)(SEQ + 1) * 16; i += GT) {
                const int pi = (int)(i >> 4), fi = (int)(i & 15); const double pos = pi < SEQ ? (double)pi : 16384.0;
                double iv = P.invf[0];
#define IV(k) if (fi == k) iv = P.invf[k]
                IV(1); IV(2); IV(3); IV(4); IV(5); IV(6); IV(7); IV(8); IV(9); IV(10); IV(11); IV(12); IV(13); IV(14); IV(15);
#undef IV
                double s, c; sincos_d(pos * iv, s, c);
                rope[(size_t)pi * 32 + fi] = (float)c; rope[(size_t)pi * 32 + 16 + fi] = (float)s;
            }
        }
    }
    if (G == 0x7fffffff) grid.sync();
    GRID_BAR();

    for (int gi = 0; gi < NGEMM; ++gi) {
        if (gi == 2) {
            int t_ = threadIdx.x; asm volatile("" : "+v"(t_)); const int tid = t_, lane = tid & 63, wave = __builtin_amdgcn_readfirstlane(tid >> 6); (void)lane; (void)wave;
            GAS unsigned char* ws = ldp(lds, 21); GAS float* out = (GAS float*)ldp(lds, 20);
            const GAS float* mix_norm = (const GAS float*)ldp(lds, 8); const GAS float* state_pool = (const GAS float*)ldp(lds, 2);
            const GAS float* ssq = (const GAS float*)(ws + WS_SSQ); const GAS bf16_t* XB = (const GAS bf16_t*)(ws + WS_XB); GAS bf16_t* PBUF = (GAS bf16_t*)(ws + WS_PB);
#define LDH(r_) ({ const u32x2 q_ = *(const GAS u32x2*)(XB + (size_t)(r_) * D + 4 * cq); (f32x4){__uint_as_float(q_.x << 16), __uint_as_float(q_.x & 0xffff0000u), __uint_as_float(q_.y << 16), __uint_as_float(q_.y & 0xffff0000u)}; })
            LAS float* rr = (LAS float*)lds;
            for (int unit = bx; unit < MP / 64 + NS; unit += G) {
                __syncthreads();
                if (unit < MP / 64) {
                    const int R0 = unit * 64, b = R0 >> 13, t0 = R0 & (SEQ - 1);
                    if (tid < 80) { const int tt = tid - 16; float r = 0.f;
                        if (t0 + tt >= 0) { const GAS float* sp = ssq + (size_t)(R0 + tt) * 16; float s = 0.f;
#pragma unroll
                            for (int j = 0; j < 16; ++j) s += sp[j];
                            r = rsqrtf(s * (1.0f / D) + RMS_EPS); }
                        rr[tid] = r; }
                    __syncthreads();
                    const int cq = tid & 255, half = tid >> 8, gq = cq >> 6, w = 2 << gq;
                    const f32x4 gm = *(const GAS f32x4*)(mix_norm + 4 * cq);
                    const int s0 = half * 32;
                    f32x4 win = (f32x4){0.f, 0.f, 0.f, 0.f};
                    for (int i = 1; i < w; ++i) { const int tt = s0 - i; if (t0 + tt >= 0) win += LDH(R0 + tt) * rr[tt + 16] * gm; }
#pragma unroll 8
                    for (int tt = s0; tt < s0 + 32; ++tt) {
                        const f32x4 hc = LDH(R0 + tt) * rr[tt + 16] * gm;
                        win += hc;
                        const int t = t0 + tt; const float inv = 1.0f / (float)(t + 1 < w ? t + 1 : w);
                        const f32x4 p = win * inv - hc;
                        u32x2 o; o.x = cvt_pk_bf16(p[0], p[1]); o.y = cvt_pk_bf16(p[2], p[3]);
                        *(GAS u32x2*)(PBUF + (size_t)(R0 + tt) * D + 4 * cq) = o;
                        if (t >= SEQ - PB) *(GAS f32x4*)(out + O_SPP + ((size_t)b * PB + (t - (SEQ - PB))) * D + 4 * cq) = hc;
                        const int to = tt - w + 1; if (t0 + to >= 0) win -= LDH(R0 + to) * rr[to + 16] * gm;
                    }
                } else {
                    const int sb = unit - MP / 64, row = MP + sb;
                    if (tid < 256) {
                        const int cq = tid, gq = cq >> 6, w = 2 << gq;
                        const GAS float* sp = ssq + (size_t)row * 16; float s = 0.f;
#pragma unroll
                        for (int j = 0; j < 16; ++j) s += sp[j];
                        const float r = rsqrtf(s * (1.0f / D) + RMS_EPS);
                        const f32x4 gm = *(const GAS f32x4*)(mix_norm + 4 * cq);
                        const f32x4 hn = LDH(row) * r * gm;
                        f32x4 win = hn;
                        for (int i = 0; i < PB; ++i) {
                            const f32x4 pv = *(const GAS f32x4*)(state_pool + ((size_t)sb * PB + i) * D + 4 * cq);
                            if (i >= PB - (w - 1)) win += pv;
                            if (i >= 1) *(GAS f32x4*)(out + O_SPS + ((size_t)sb * PB + (i - 1)) * D + 4 * cq) = pv;
                        }
                        *(GAS f32x4*)(out + O_SPS + ((size_t)sb * PB + (PB - 1)) * D + 4 * cq) = hn;
                        const f32x4 p = win * (1.0f / (float)w) - hn;
                        u32x2 o; o.x = cvt_pk_bf16(p[0], p[1]); o.y = cvt_pk_bf16(p[2], p[3]);
                        *(GAS u32x2*)(PBUF + (size_t)row * D + 4 * cq) = o;
                    }
                }
            }
            GRID_BAR();
        }
        if (gi == 10) {
            {
                int t_ = threadIdx.x; asm volatile("" : "+v"(t_)); const int tid = t_, lane = tid & 63, wave = __builtin_amdgcn_readfirstlane(tid >> 6);
                GAS unsigned char* ws = ldp(lds, 21);
                const GAS bf16_t* KB = (const GAS bf16_t*)(ws + WS_KB); const GAS bf16_t* VB = (const GAS bf16_t*)(ws + WS_VB); const GAS bf16_t* QB = (const GAS bf16_t*)(ws + WS_QB);
                GAS bf16_t* OG = (GAS bf16_t*)(ws + WS_OG); GAS float* lse = (GAS float*)(ws + WS_LSE);
                const int qi = lane & 15, qd = lane >> 4;
                const int per = (6144 + G - 1) / G, u0 = bx * per, u1 = (u0 + per < 6144) ? u0 + per : 6144;
                u32x4 kr[4], vr[4]; bf16x8 qn[4];
#define DEC(u_, gq_, b_, h_, cls_, n_, dl_) const int gq_ = (u_) / 2048, b_ = ((u_) >> 9) & 3, h_ = ((u_) >> 6) & 7, blk_##u_ = (u_) & 63; const int dl_ = gq_ == 0 ? 1 : (gq_ == 1 ? 4 : 16); const int nbk_##u_ = 64 / dl_, cls_ = blk_##u_ / nbk_##u_, n_ = blk_##u_ % nbk_##u_
#define ISSUE(gq_, b_, h_, cls_, n_, dl_) do { \
                    _Pragma("unroll") for (int i = 0; i < 4; ++i) { const int c = tid + 512 * i, row = c >> 4, ch = c & 15; \
                        const size_t so = ((size_t)(b_) * SEQ + (size_t)((128 * (n_) + row) * (dl_) + (cls_))) * D + (h_) * HD + ch * 8; kr[i] = *(const GAS u32x4*)(KB + so); vr[i] = *(const GAS u32x4*)(VB + so); } \
                    { const size_t qrow_ = (size_t)(b_) * SEQ + (size_t)((128 * (n_) + 16 * wave + qi) * (dl_) + (cls_)); \
                      _Pragma("unroll") for (int s = 0; s < 4; ++s) qn[s] = *(const GAS bf16x8*)(QB + qrow_ * NQ + ((gq_) * 8 + (h_)) * HD + 32 * s + 8 * qd); } } while (0)
                int rot = 0; bool chained = false;
                { const int uu = u0 < 6144 ? u0 : 6143; DEC(uu, g0, b0, h0, c0, n0, d0); ISSUE(g0, b0, h0, c0, n0, d0); }
                for (int u = u0; u < u1; ++u) {
                    DEC(u, gq, b, h, cls, n, dl);
                    __syncthreads();
                    {
                        const unsigned rx = (unsigned)rot << 15;
#pragma unroll
                        for (int i = 0; i < 4; ++i) { const int c = tid + 512 * i, row = c >> 4, ch = c & 15;
                            const unsigned oo = (unsigned)kv_off(128 + row, ch) ^ rx; *(LAS u32x4*)(lds + oo) = kr[i]; *(LAS u32x4*)(lds + 65536 + oo) = vr[i];
                        }
                        if (!chained) {
#pragma unroll
                            for (int i = 0; i < 4; ++i) { const int c = tid + 512 * i, row = c >> 4, ch = c & 15;
                                u32x4 kp = (u32x4){0u, 0u, 0u, 0u}, vp = (u32x4){0u, 0u, 0u, 0u};
                                if (n > 0) { const size_t sp = ((size_t)b * SEQ + (size_t)((128 * (n - 1) + row) * dl + cls)) * D + h * HD + ch * 8; kp = *(const GAS u32x4*)(KB + sp); vp = *(const GAS u32x4*)(VB + sp); }
                                const unsigned op = (unsigned)kv_off(row, ch) ^ rx; *(LAS u32x4*)(lds + op) = kp; *(LAS u32x4*)(lds + 65536 + op) = vp; }
                        }
                    }
                    bf16x8 qf[4];
#pragma unroll
                    for (int s = 0; s < 4; ++s) qf[s] = qn[s];
                    __syncthreads();
                    const int rotc = rot;
                    { const int un = (u + 1 < u1) ? u + 1 : u;
                      DEC(un, g1, b1, h1, c1, n1, d1); const bool ch1 = (n1 != 0) && ((un & 63) != 0) && (un != u);
                      ISSUE(g1, b1, h1, c1, n1, d1);
                      chained = ch1; rot = ch1 ? (rot ^ 1) : 0; }
                    const unsigned rx = (unsigned)rotc << 15;
                    const int ii = 16 * wave + qi; const size_t qrow = (size_t)b * SEQ + (size_t)((128 * n + ii) * dl + cls);
                    const int kw = 16 * wave;
                    f32x4 Sx[9];
                    {
                        bf16x8 kf[2][4];
#pragma unroll
                        for (int s = 0; s < 4; ++s) kf[0][s] = *(const LAS bf16x8*)(lds + ((unsigned)kv_off(kw + qi, 4 * s + qd) ^ rx));
#pragma unroll
                        for (int j = 0; j < 9; ++j) {
                            if (j < 8) {
#pragma unroll
                                for (int s = 0; s < 4; ++s) kf[(j + 1) & 1][s] = *(const LAS bf16x8*)(lds + ((unsigned)kv_off(kw + 16 * (j + 1) + qi, 4 * s + qd) ^ rx));
                            }
                            f32x4 a = (f32x4){0.f, 0.f, 0.f, 0.f};
#pragma unroll
                            for (int s = 0; s < 4; ++s) a = __builtin_amdgcn_mfma_f32_16x16x32_bf16(kf[j & 1][s], qf[s], a, 0, 0, 0);
                            if (j == 0) {
#pragma unroll
                                for (int e = 0; e < 4; ++e) a[e] = (4 * qd + e >= qi) ? a[e] : -INFINITY; }
                            if (j == 8) {
#pragma unroll
                                for (int e = 0; e < 4; ++e) a[e] = (4 * qd + e <= qi) ? a[e] : -INFINITY; }
                            Sx[j] = a;
                        }
                    }
                    if (n == 0) {
#pragma unroll
                        for (int j = 0; j < 8; ++j) if (wave + j < 8) Sx[j] = (f32x4){-INFINITY, -INFINITY, -INFINITY, -INFINITY};
                    }
                    float mx = -INFINITY;
#pragma unroll
                    for (int kt = 0; kt < 9; ++kt) mx = fmaxf(mx, fmaxf(fmaxf(Sx[kt][0], Sx[kt][1]), fmaxf(Sx[kt][2], Sx[kt][3])));
                    mx = fmaxf(mx, __shfl_xor(mx, 16)); mx = fmaxf(mx, __shfl_xor(mx, 32));
                    float ls = 0.f;
#pragma unroll
                    for (int kt = 0; kt < 9; ++kt)
#pragma unroll
                        for (int e = 0; e < 4; ++e) { const float p = __builtin_amdgcn_exp2f(Sx[kt][e] - mx); Sx[kt][e] = p; ls += p; }
                    ls += __shfl_xor(ls, 16); ls += __shfl_xor(ls, 32);
                    f32x4 O[8];
#pragma unroll
                    for (int dt = 0; dt < 8; ++dt) O[dt] = (f32x4){0.f, 0.f, 0.f, 0.f};
                    const int q4 = qi >> 2, p4 = qi & 3, sw = (q4 << 2) | qd;
                    const unsigned vlane = 65536u + 256u * (unsigned)(4 * qd + q4) + 8u * (unsigned)(p4 & 1);
#define TRR(dst, addr) asm volatile("ds_read_b64_tr_b16 %0, %1" : "=&v"(dst) : "v"(addr) : "memory")
#define TRBATCH(i_, L_, H_) do { const int ks_ = (i_) >> 1, dh_ = (i_) & 1; const int tl_ = 2 * ks_, th_ = (2 * ks_ + 1 < 9) ? 2 * ks_ + 1 : 8; \
                        const unsigned blo_ = ((256u * (unsigned)(kw + 16 * tl_)) ^ rx) + vlane, bhi_ = ((256u * (unsigned)(kw + 16 * th_)) ^ rx) + vlane; \
                        _Pragma("unroll") for (int d4 = 0; d4 < 4; ++d4) { const int dt_ = 4 * dh_ + d4; const unsigned co_ = 16u * (unsigned)((2 * dt_ + (p4 >> 1)) ^ sw); const unsigned a0_ = blo_ + co_, a1_ = bhi_ + co_; TRR(L_[d4], a0_); TRR(H_[d4], a1_); } } while (0)
#define PVMMA(i_, L_, H_) do { const int ks_ = (i_) >> 1, dh_ = (i_) & 1; \
                        bf16x8 pf_; { u32x4 t_; t_.x = cvt_pk_bf16(Sx[2 * ks_][0], Sx[2 * ks_][1]); t_.y = cvt_pk_bf16(Sx[2 * ks_][2], Sx[2 * ks_][3]); \
                            if (2 * ks_ + 1 < 9) { t_.z = cvt_pk_bf16(Sx[(2 * ks_ + 1 < 9) ? 2 * ks_ + 1 : 8][0], Sx[(2 * ks_ + 1 < 9) ? 2 * ks_ + 1 : 8][1]); t_.w = cvt_pk_bf16(Sx[(2 * ks_ + 1 < 9) ? 2 * ks_ + 1 : 8][2], Sx[(2 * ks_ + 1 < 9) ? 2 * ks_ + 1 : 8][3]); } else { t_.z = 0u; t_.w = 0u; } \
                            pf_ = __builtin_bit_cast(bf16x8, t_); } \
                        _Pragma("unroll") for (int d4 = 0; d4 < 4; ++d4) { const int dt_ = 4 * dh_ + d4; const bf16x8 vf_ = (bf16x8){L_[d4][0], L_[d4][1], L_[d4][2], L_[d4][3], H_[d4][0], H_[d4][1], H_[d4][2], H_[d4][3]}; \
                            O[dt_] = __builtin_amdgcn_mfma_f32_16x16x32_bf16(vf_, pf_, O[dt_], 0, 0, 0); } } while (0)
#define TRWAIT(cnt_, L_, H_) asm volatile("s_waitcnt lgkmcnt(" #cnt_ ")" : "+v"(L_[0]), "+v"(L_[1]), "+v"(L_[2]), "+v"(L_[3]), "+v"(H_[0]), "+v"(H_[1]), "+v"(H_[2]), "+v"(H_[3]) :: "memory")
                    {
                        s16x4 la[4], ha[4], lb[4], hb[4];
                        TRBATCH(0, la, ha);
                        TRBATCH(1, lb, hb); TRWAIT(8, la, ha); PVMMA(0, la, ha);
                        TRBATCH(2, la, ha); TRWAIT(8, lb, hb); PVMMA(1, lb, hb);
                        TRBATCH(3, lb, hb); TRWAIT(8, la, ha); PVMMA(2, la, ha);
                        TRBATCH(4, la, ha); TRWAIT(8, lb, hb); PVMMA(3, lb, hb);
                        TRBATCH(5, lb, hb); TRWAIT(8, la, ha); PVMMA(4, la, ha);
                        TRBATCH(6, la, ha); TRWAIT(8, lb, hb); PVMMA(5, lb, hb);
                        TRBATCH(7, lb, hb); TRWAIT(8, la, ha); PVMMA(6, la, ha);
                        TRBATCH(8, la, ha); TRWAIT(8, lb, hb); PVMMA(7, lb, hb);
                        TRBATCH(9, lb, hb); TRWAIT(8, la, ha); PVMMA(8, la, ha);
                        TRWAIT(0, lb, hb); PVMMA(9, lb, hb);
                    }
#undef TRWAIT
#undef PVMMA
#undef TRBATCH
#undef TRR
                    const float inv = 1.0f / ls;
                    GAS bf16_t* od = OG + ((size_t)gq * MT + qrow) * D + h * HD + 4 * qd;
#pragma unroll
                    for (int dt = 0; dt < 8; ++dt) { u32x2 w; w.x = cvt_pk_bf16(O[dt][0] * inv, O[dt][1] * inv); w.y = cvt_pk_bf16(O[dt][2] * inv, O[dt][3] * inv); *(GAS u32x2*)(od + 16 * dt) = w; }
                    if (qd == 0) lse[((size_t)gq * MT + qrow) * 8 + h] = mx + __builtin_amdgcn_logf(ls);
                }
#undef ISSUE
#undef DEC
            }
            {
                int t_ = threadIdx.x; asm volatile("" : "+v"(t_)); const int tid = t_, lane = tid & 63, wave = __builtin_amdgcn_readfirstlane(tid >> 6);
                GAS unsigned char* ws = ldp(lds, 21); const GAS float* out = (const GAS float*)ldp(lds, 20);
                const GAS float* cache_k = (const GAS float*)ldp(lds, 3); const GAS float* cache_v = (const GAS float*)ldp(lds, 4);
                const GAS bf16_t* QB = (const GAS bf16_t*)(ws + WS_QB); GAS bf16_t* PBUF = (GAS bf16_t*)(ws + WS_PB);
                LAS float* sc = (LAS float*)lds;
                LAS f32x4* red = (LAS f32x4*)(lds + 2048);
                for (int unit = bx; unit < NS * NH; unit += G) {
                    const int b = unit >> 3, h = unit & 7;
                    __syncthreads();
                    const int l16 = lane & 15, kq = lane >> 4;
#pragma unroll
                    for (int pass = 0; pass < 13; ++pass) {
                        const int pi = pass * 32 + wave * 4 + kq, pc = pi < 387 ? pi : 386;
                        const int gq = pc / 129, j = pc % 129, dl = gq == 0 ? 1 : (gq == 1 ? 4 : 16);
                        const GAS float* kp = (j == 0) ? out + O_CKS + ((size_t)b * WMAX + (WMAX - 1)) * D : cache_k + ((size_t)b * WMAX + (WMAX - dl * j)) * D;
                        const f32x4 k0 = *(const GAS f32x4*)(kp + h * HD + 8 * l16), k1 = *(const GAS f32x4*)(kp + h * HD + 8 * l16 + 4);
                        const u32x4 qv = *(const GAS u32x4*)(QB + (size_t)(MP + b) * NQ + (gq * 8 + h) * HD + 8 * l16);
                        float s = k0[0] * __uint_as_float(qv.x << 16) + k0[1] * __uint_as_float(qv.x & 0xffff0000u) + k0[2] * __uint_as_float(qv.y << 16) + k0[3] * __uint_as_float(qv.y & 0xffff0000u)
                                + k1[0] * __uint_as_float(qv.z << 16) + k1[1] * __uint_as_float(qv.z & 0xffff0000u) + k1[2] * __uint_as_float(qv.w << 16) + k1[3] * __uint_as_float(qv.w & 0xffff0000u);
                        s += __shfl_xor(s, 1); s += __shfl_xor(s, 2); s += __shfl_xor(s, 4); s += __shfl_xor(s, 8);
                        if (l16 == 0 && pi < 387) sc[pi] = s;
                    }
                    __syncthreads();
                    if (wave == 0) {
                        float v[7]; float mx = -INFINITY;
#pragma unroll
                        for (int i = 0; i < 7; ++i) { const int pi = lane + 64 * i; v[i] = pi < 387 ? sc[pi] : -INFINITY; mx = fmaxf(mx, v[i]); }
                        mx = wave_max(mx); float ls = 0.f;
#pragma unroll
                        for (int i = 0; i < 7; ++i) { const int pi = lane + 64 * i; const float p = __builtin_amdgcn_exp2f(v[i] - mx); ls += p; if (pi < 387) sc[pi] = p; }
                        ls = wave_sum(ls);
                        if (lane == 0) sc[500] = 1.0f / ls;
                    }
                    __syncthreads();
                    {
                        const int part = tid >> 5, d4 = (tid & 31) * 4; f32x4 acc = (f32x4){0.f, 0.f, 0.f, 0.f};
#pragma unroll 5
                        for (int it = 0; it < 25; ++it) {
                            const int pi = part + 16 * it, pc = pi < 387 ? pi : 386;
                            const int gq = pc / 129, j = pc % 129, dl = gq == 0 ? 1 : (gq == 1 ? 4 : 16);
                            const GAS float* vp = (j == 0) ? out + O_CVS + ((size_t)b * WMAX + (WMAX - 1)) * D : cache_v + ((size_t)b * WMAX + (WMAX - dl * j)) * D;
                            const float p = pi < 387 ? sc[pc] : 0.f;
                            acc += *(const GAS f32x4*)(vp + h * HD + d4) * p;
                        }
                        red[part * 32 + (tid & 31)] = acc;
                    }
                    __syncthreads();
                    if (tid < 128) { const LAS float* rf = (const LAS float*)red; float o = 0.f;
#pragma unroll
                        for (int pt = 0; pt < 16; ++pt) o += rf[pt * 128 + tid];
                        o *= sc[500];
                        PBUF[(size_t)(MP + b) * D + h * HD + tid] = (bf16_t)(cvt_pk_bf16(o, 0.f) & 0xffffu); }
                }
            }
            GRID_BAR();
            {
                int t_ = threadIdx.x; asm volatile("" : "+v"(t_)); const int tid = t_, lane = tid & 63, wave = __builtin_amdgcn_readfirstlane(tid >> 6); (void)lane; (void)wave;
                GAS unsigned char* ws = ldp(lds, 21);
                const GAS bf16_t* OG = (const GAS bf16_t*)(ws + WS_OG); const GAS float* lse = (const GAS float*)(ws + WS_LSE); GAS bf16_t* PBUF = (GAS bf16_t*)(ws + WS_PB);
                const size_t gtid = (size_t)bx * 512 + tid, GT = (size_t)G * 512;
                for (size_t i = gtid; i < (size_t)MP * 128; i += GT) {
                    const size_t row = i >> 7; const int ch = (int)(i & 127), h = ch >> 4;
                    const float l0 = lse[((size_t)0 * MT + row) * 8 + h], l1 = lse[((size_t)1 * MT + row) * 8 + h], l2 = lse[((size_t)2 * MT + row) * 8 + h];
                    const float m = fmaxf(l0, fmaxf(l1, l2));
                    float w0 = __builtin_amdgcn_exp2f(l0 - m), w1 = __builtin_amdgcn_exp2f(l1 - m), w2 = __builtin_amdgcn_exp2f(l2 - m);
                    const float inv = 1.0f / (w0 + w1 + w2); w0 *= inv; w1 *= inv; w2 *= inv;
                    const u32x4 a = *(const GAS u32x4*)(OG + ((size_t)0 * MT + row) * D + ch * 8), bb = *(const GAS u32x4*)(OG + ((size_t)1 * MT + row) * D + ch * 8), c = *(const GAS u32x4*)(OG + ((size_t)2 * MT + row) * D + ch * 8);
                    u32x4 o;
#pragma unroll
                    for (int e = 0; e < 4; ++e) {
                        const float lo = w0 * __uint_as_float(a[e] << 16) + w1 * __uint_as_float(bb[e] << 16) + w2 * __uint_as_float(c[e] << 16);
                        const float hi = w0 * __uint_as_float(a[e] & 0xffff0000u) + w1 * __uint_as_float(bb[e] & 0xffff0000u) + w2 * __uint_as_float(c[e] & 0xffff0000u);
                        o[e] = cvt_pk_bf16(lo, hi);
                    }
                    *(GAS u32x4*)(PBUF + row * D + ch * 8) = o;
                }
            }
            GRID_BAR();
        }
        {
            const LAS unsigned* wv = (const LAS unsigned*)(lds + TAB_OFF + 256 + gi * 64);
            unsigned v[16];
#pragma unroll
            for (int j = 0; j < 16; ++j) v[j] = __builtin_amdgcn_readfirstlane(wv[j]);
#define U64(a, b) (((unsigned long long)(b) << 32) | (a))
            pg8::Gemm g{(const GAS bf16_t*)U64(v[0], v[1]), (const GAS bf16_t*)U64(v[2], v[3]), MP, (int)v[8], (int)v[9], (int)v[10], (int)v[11]};
            GAS unsigned char* ws = ldp(lds, 21);
            EpiAll E{(int)v[12], (GAS void*)U64(v[4], v[5]), (GAS void*)U64(v[6], v[7]), (GAS float*)(ws + WS_SSQ), (const GAS float*)(ws + WS_ROPE), (GAS float*)ldp(lds, 20), __uint_as_float(v[14]), lds};
#undef U64
            { const int item = G - 1 - bx; if (item < (g.N >> 6)) skinny_item(lds, g, E, item); }
            pg8::StaticOrder S; S.init(MP, g.N, G, bx);
            pg8::gemm_phase(lds, g, S, E);
            if (v[13]) GRID_BAR();
        }
    }
    {
        int t_ = threadIdx.x; asm volatile("" : "+v"(t_)); const int tid = t_, lane = tid & 63, wave = __builtin_amdgcn_readfirstlane(tid >> 6);
        GAS unsigned char* ws = ldp(lds, 21); GAS float* out = (GAS float*)ldp(lds, 20); const GAS float* final_norm = (const GAS float*)ldp(lds, 19);
        const GAS float* ssq = (const GAS float*)(ws + WS_SSQ); const GAS bf16_t* XB = (const GAS bf16_t*)(ws + WS_XB);
        const int gw = bx * 8 + wave, NGW = G * 8;
        const GAS f32x4* gn = (const GAS f32x4*)final_norm + lane;
        const f32x4 g0 = gn[0], g1 = gn[64], g2 = gn[128], g3 = gn[192];
#pragma unroll 2
        for (int row = gw; row < MV; row += NGW) {
            const f32x4 s4 = *(const GAS f32x4*)(ssq + (size_t)row * 16 + 4 * (lane & 3));
            float s = (s4[0] + s4[1]) + (s4[2] + s4[3]); s += __shfl_xor(s, 1); s += __shfl_xor(s, 2);
            const float r = rsqrtf(s * (1.0f / D) + RMS_EPS);
            const GAS u32x2* xr = (const GAS u32x2*)(XB + (size_t)row * D) + lane;
            GAS f32x4* yo = (GAS f32x4*)(out + (size_t)row * D) + lane;
            const u32x2 q0 = xr[0], q1 = xr[64], q2 = xr[128], q3 = xr[192];
#define UNPK(q_) ((f32x4){__uint_as_float((q_).x << 16), __uint_as_float((q_).x & 0xffff0000u), __uint_as_float((q_).y << 16), __uint_as_float((q_).y & 0xffff0000u)})
            __builtin_nontemporal_store(UNPK(q0) * r * g0, yo); __builtin_nontemporal_store(UNPK(q1) * r * g1, yo + 64);
            __builtin_nontemporal_store(UNPK(q2) * r * g2, yo + 128); __builtin_nontemporal_store(UNPK(q3) * r * g3, yo + 192);
#undef UNPK
        }
    }
}

extern "C" void kernel_launch(void* const* d_in, const int* in_sizes, int n_in, void* d_out, int out_size, void* d_ws, size_t ws_size, hipStream_t stream) {
    static int grid = 0;
    if (grid == 0) {
        if (n_in != 20 || ws_size < WS_END) { fprintf(stderr, "kernel_launch: unexpected n_in %d / ws %zu (need %zu)\n", n_in, ws_size, (size_t)WS_END); grid = -1; return; }
        int dev = 0, cus = 0, per_cu = 0;
        hipGetDevice(&dev); hipDeviceGetAttribute(&cus, hipDeviceAttributeMultiprocessorCount, dev);
        hipFuncSetAttribute((const void*)yoco_fwd, hipFuncAttributeMaxDynamicSharedMemorySize, LDS_BYTES);
        hipOccupancyMaxActiveBlocksPerMultiprocessor(&per_cu, (const void*)yoco_fwd, 512, LDS_BYTES);
        if (per_cu < 1) { fprintf(stderr, "kernel_launch: occupancy query says %d blocks/CU\n", per_cu); per_cu = 1; }
        (void)hipGetLastError();
        grid = cus * 1;
    }
    if (grid < 0) return;
    Params p{};
    for (int i = 0; i < 20; ++i) p.in[i] = (const float*)d_in[i];
    p.out = (float*)d_out; p.ws = (unsigned char*)d_ws;
    static const double invf[16] = {1.0, 0.44036660267178046, 0.19392274474868576, 0.08539710028576561, 0.03760603093086393, 0.016560440080994446, 0.007292664737217109, 0.003211445994752591,
                                    0.001414213562373095, 0.000622772421914596, 0.0002742481756762073, 0.00012076973741146504, 5.318295896944988e-05, 2.341999896140934e-05, 1.031338537721246e-05, 4.5416704806078695e-06};
    for (int i = 0; i < 16; ++i) p.invf[i] = invf[i];
    (void)hipMemsetAsync(d_ws, 0, 16384, stream);
    void* args[] = {&p};
    hipError_t e = hipLaunchCooperativeKernel((const void*)yoco_fwd, dim3(grid), dim3(512), args, LDS_BYTES, stream);
    if (e != hipSuccess) fprintf(stderr, "cooperative launch failed: %s (grid %d)\n", hipGetErrorString(e), grid);
}
```

```cpp
#include <hip/hip_runtime.h>
#include <hip/hip_cooperative_groups.h>
#include <cstdio>
#include <cstdint>
namespace cg = cooperative_groups;

#define LAS __attribute__((address_space(3)))
#if defined(__HIP_DEVICE_COMPILE__)
#define GAS __attribute__((address_space(1)))
#else
#define GAS
#endif
typedef unsigned short bf16_t;
typedef short bf16x8 __attribute__((ext_vector_type(8)));
typedef short s16x4 __attribute__((ext_vector_type(4)));
typedef float f32x4 __attribute__((ext_vector_type(4)));
typedef float f32x2 __attribute__((ext_vector_type(2)));
typedef unsigned u32x4 __attribute__((ext_vector_type(4)));
typedef unsigned u32x2 __attribute__((ext_vector_type(2)));

constexpr int D = 1024, FF = 2816, NB = 4, SEQ = 8192, MP = NB * SEQ  , NS = 32  ;
constexpr int MT = MP + 256;
constexpr int MV = MP + NS;
constexpr int NH = 8, HD = 128, WMAX = 2048, PB = 15;
constexpr int NQ = 3 * D;
constexpr float RMS_EPS = 1e-6f;
constexpr float QSCALE = 0.08838834764831845f * 1.4426950408889634f;

constexpr size_t O_YP = 0, O_YS = (size_t)MP * D, O_SPP = O_YS + (size_t)NS * D, O_SPS = O_SPP + (size_t)NB * PB * D,
                 O_CKP = O_SPS + (size_t)NS * PB * D, O_CVP = O_CKP + (size_t)NB * WMAX * D, O_CKS = O_CVP + (size_t)NB * WMAX * D,
                 O_CVS = O_CKS + (size_t)NS * WMAX * D;

constexpr size_t MiB = 1u << 20;
constexpr size_t WS_WIN = 1 * MiB;
constexpr size_t WIN_BYTES = (size_t)2 * FF * D * 2;
constexpr size_t WS_WOUT = WS_WIN + 4 * WIN_BYTES;
constexpr size_t WOUT_BYTES = (size_t)D * FF * 2;
constexpr size_t WS_WPG = WS_WOUT + 4 * WOUT_BYTES;
constexpr size_t WS_WPO = WS_WPG + (size_t)D * 256 * 2;
constexpr size_t WS_WKV = WS_WPO + (size_t)D * D * 2;
constexpr size_t WS_WQ = WS_WKV + (size_t)2 * D * D * 2;
constexpr size_t WS_WO = WS_WQ + (size_t)NQ * D * 2;
constexpr size_t WS_ROPE = WS_WO + (size_t)D * D * 2;
constexpr size_t WS_SSQ = WS_ROPE + (size_t)8200 * 32 * 4;
constexpr size_t WS_LSE = WS_SSQ + (size_t)MT * 16 * 4;
constexpr size_t WS_XF = (WS_LSE + (size_t)3 * MT * 8 * 4 + 4095) & ~(size_t)4095;
constexpr size_t WS_XB = WS_XF + (size_t)MT * D * 4;
constexpr size_t WS_ACT = WS_XB + (size_t)MT * D * 2;
constexpr size_t WS_PB = WS_ACT + (size_t)MT * FF * 2;
constexpr size_t WS_ZB = WS_PB + (size_t)MT * D * 2;
constexpr size_t WS_KB = WS_ZB + (size_t)MT * D * 2;
constexpr size_t WS_VB = WS_KB + (size_t)MT * D * 2;
constexpr size_t WS_QB = WS_VB + (size_t)MT * D * 2;
constexpr size_t WS_OG = WS_QB + (size_t)MT * NQ * 2;
constexpr size_t WS_END = WS_OG + (size_t)3 * MT * D * 2;

constexpr int LDS_BYTES = 147456;

struct Params {
    const float* in[20];
    float* out;
    unsigned char* ws;
    double invf[16];
};

__device__ __forceinline__ unsigned cvt_pk_bf16(float lo, float hi) { unsigned r; asm volatile("v_cvt_pk_bf16_f32 %0, %1, %2" : "=v"(r) : "v"(lo), "v"(hi)); return r; }
__device__ __forceinline__ float bf2f(unsigned short b) { return __uint_as_float((unsigned)b << 16); }
__device__ __forceinline__ float wave_sum(float v) {
#pragma unroll
    for (int o = 1; o < 64; o <<= 1) v += __shfl_xor(v, o);
    return v;
}
__device__ __forceinline__ float wave_max(float v) {
#pragma unroll
    for (int o = 1; o < 64; o <<= 1) v = fmaxf(v, __shfl_xor(v, o));
    return v;
}

namespace pg8 {
constexpr int BM = 256, BK = 64, HALF = 128, HTB = HALF * BK * 2, STAGE_BYTES = 8 * HTB, NXCD = 8, WGM = 8;
__host__ __device__ __forceinline__ int lds_byte(int r, int c) { const int st = (r >> 4) * 2 + (c >> 5), rr = r & 15, cc = c & 31, ob = rr * 64 + cc * 2; return st * 1024 + (ob ^ (((ob >> 9) & 1) << 5)); }
__host__ __device__ __forceinline__ void stage_rc(int b, int& R, int& C) { const int st = b / 1024, sb = b % 1024, swz = sb ^ (((sb >> 9) & 1) << 5); R = (st >> 1) * 16 + swz / 64; C = (st & 1) * 32 + (swz % 64) / 2; }
__host__ __device__ __forceinline__ int perm32(int rho) { const int n = rho >> 4, i = rho & 15; return 8 * (i >> 2) + 4 * n + (i & 3); }

struct Unit { int pm, pn, ui; };
struct Gemm { const GAS bf16_t* A; const GAS bf16_t* Bt; int M, N, K, lda, acol; };

struct StaticOrder {
    int nM, nN, nwg, G, c;
    __device__ void init(int M, int N, int G_, int c_) { nM = M / BM; nN = N / BM; nwg = nM * nN; G = G_; c = c_; }
    __device__ bool next(int i, Unit& u) const {
        const long L = (long)i * G + c; if (L >= nwg) return false;
        int wgid = (int)L; { const int q = nwg / NXCD, r = nwg % NXCD, xcd = wgid % NXCD, off = wgid / NXCD; wgid = (xcd < r ? xcd * (q + 1) : r * (q + 1) + (xcd - r) * q) + off; }
        const int nig = WGM * nN, gid = wgid / nig, fm = gid * WGM, gsz = (nM - fm) < WGM ? (nM - fm) : WGM;
        u.pm = fm + ((wgid % nig) % gsz); u.pn = (wgid % nig) / gsz; u.ui = i; return true;
    }
};

template <class Epi>
__device__ __forceinline__ void gemm_phase(LAS unsigned char* lds, const Gemm g, const StaticOrder& S, const Epi& E) {
    const bool PERMR = E.perm();
    const int tid = threadIdx.x, wid = __builtin_amdgcn_readfirstlane(tid >> 6), lane = tid & 63, wr = wid >> 2, wc = wid & 3, fr = lane & 15, fq = lane >> 4;
    const int K = g.K, nt = K / BK;
    unsigned voffA[2], voffB[2];
#pragma unroll
    for (int i = 0; i < 2; ++i) { int R, C; stage_rc(tid * 16 + i * 8192, R, C); const int Rb = PERMR ? ((R & ~31) + perm32(R & 31)) : R;
        voffA[i] = (unsigned)(R * g.lda + C) * 2u; voffB[i] = (unsigned)(Rb * K + C) * 2u; }
    const size_t kstep = (size_t)(BK * 2);
    const size_t hstepA = (size_t)HALF * g.lda * 2, hstepB = (size_t)HALF * K * 2;
    const unsigned ldsw = (unsigned)wid * 1024u;
    const int aoff = lds_byte(wr * 64 + fr, fq * 8), boff = lds_byte(wc * 32 + fr, fq * 8);
#define PG8_SA(b, h) (((b) * 2 + (h)) * HTB)
#define PG8_SB(b, h) ((4 + (b) * 2 + (h)) * HTB)
#define PG8_STAGE(bufoff, gbase, voff) do { _Pragma("unroll") for (int _i = 0; _i < 2; ++_i) \
        __builtin_amdgcn_global_load_lds((const unsigned*)((const char*)(gbase) + (voff)[_i]), (LAS unsigned*)(lds + (bufoff) + ldsw + _i * 8192), 16, 0, 0); } while (0)
#define PG8_LDA(dst, b, h) do { _Pragma("unroll") for (int m = 0; m < 4; ++m) _Pragma("unroll") for (int k = 0; k < 2; ++k) dst[m][k] = *(const LAS bf16x8*)(lds + PG8_SA(b, h) + aoff + m * 2048 + k * 1024); } while (0)
#define PG8_LDB(dst, b, h) do { _Pragma("unroll") for (int n = 0; n < 2; ++n) _Pragma("unroll") for (int k = 0; k < 2; ++k) dst[n][k] = *(const LAS bf16x8*)(lds + PG8_SB(b, h) + boff + n * 2048 + k * 1024); } while (0)
#define PG8_MMA(ai, bj, At, Bt) do { __builtin_amdgcn_s_setprio(1); _Pragma("unroll") for (int m = 0; m < 4; ++m) _Pragma("unroll") for (int n = 0; n < 2; ++n) _Pragma("unroll") for (int k = 0; k < 2; ++k) \
        acc[ai][bj][m][n] = __builtin_amdgcn_mfma_f32_16x16x32_bf16(Bt[n][k], At[m][k], acc[ai][bj][m][n], 0, 0, 0); __builtin_amdgcn_s_setprio(0); } while (0)
#define PG8_WAIT_V(n) asm volatile("s_waitcnt vmcnt(" #n ")" ::: "memory")
#define PG8_WAIT_L(n) asm volatile("s_waitcnt lgkmcnt(" #n ")" ::: "memory")
#define PG8_BAR __builtin_amdgcn_s_barrier()
#define PG8_SCHED __builtin_amdgcn_sched_barrier(0)
    Unit cur, nxt; int ui = 0;
    if (!S.next(0, cur)) return;
    f32x4 acc[2][2][4][2];
#pragma unroll
    for (int a = 0; a < 2; ++a)
#pragma unroll
        for (int b = 0; b < 2; ++b)
#pragma unroll
            for (int m = 0; m < 4; ++m)
#pragma unroll
                for (int n = 0; n < 2; ++n) acc[a][b][m][n] = (f32x4){0.f, 0.f, 0.f, 0.f};
    bf16x8 At[4][2], B0[2][2], B1[2][2];
    const char* cA = (const char*)g.A + (size_t)cur.pm * 2 * hstepA + (size_t)cur.pn * g.acol * 2;
    const char* cB = (const char*)g.Bt + (size_t)cur.pn * 2 * hstepB;
    PG8_STAGE(PG8_SB(0, 0), cB, voffB); PG8_STAGE(PG8_SB(0, 1), cB + hstepB, voffB); PG8_STAGE(PG8_SA(0, 0), cA, voffA); PG8_STAGE(PG8_SA(0, 1), cA + hstepA, voffA);
    if (wr == 1) PG8_BAR;
    PG8_WAIT_V(2); PG8_BAR;
    PG8_STAGE(PG8_SB(1, 0), cB + kstep, voffB); PG8_STAGE(PG8_SA(1, 0), cA + kstep, voffA); PG8_STAGE(PG8_SB(1, 1), cB + hstepB + kstep, voffB);
    PG8_WAIT_V(6); PG8_BAR;
    for (;;) {
        const bool has_next = S.next(ui + 1, nxt);
        const char* nA = has_next ? (const char*)g.A + (size_t)nxt.pm * 2 * hstepA + (size_t)nxt.pn * g.acol * 2 : cA;
        const char* nB = has_next ? (const char*)g.Bt + (size_t)nxt.pn * 2 * hstepB : cB;
        for (int t = 0; t < nt; t += 2) {
            const bool last = (t == nt - 2);
            const char* a1 = cA + (size_t)(t + 1) * kstep;
            const char* a2 = last ? nA : cA + (size_t)(t + 2) * kstep; const char* b2 = last ? nB : cB + (size_t)(t + 2) * kstep;
            const char* a3 = a2 + kstep; const char* b3 = b2 + kstep;
            PG8_LDB(B0, 0, 0); PG8_LDB(B1, 0, 1); PG8_SCHED; PG8_LDA(At, 0, 0); PG8_STAGE(PG8_SA(1, 1), a1 + hstepA, voffA);
            PG8_WAIT_V(8); PG8_WAIT_L(0); PG8_BAR; PG8_MMA(0, 0, At, B0); PG8_MMA(0, 1, At, B1); PG8_BAR; PG8_SCHED;
            PG8_LDA(At, 0, 1); PG8_STAGE(PG8_SB(0, 0), b2, voffB); PG8_STAGE(PG8_SB(0, 1), b2 + hstepB, voffB); PG8_STAGE(PG8_SA(0, 0), a2, voffA);
            PG8_WAIT_V(8); PG8_WAIT_L(0); PG8_BAR; PG8_MMA(1, 0, At, B0); PG8_MMA(1, 1, At, B1); PG8_BAR; PG8_SCHED;
            PG8_LDB(B0, 1, 0); PG8_LDB(B1, 1, 1); PG8_SCHED; PG8_LDA(At, 1, 0); PG8_STAGE(PG8_SA(0, 1), a2 + hstepA, voffA);
            PG8_WAIT_V(8); PG8_WAIT_L(0); PG8_BAR; PG8_MMA(0, 0, At, B0); PG8_MMA(0, 1, At, B1); PG8_BAR; PG8_SCHED;
            PG8_LDA(At, 1, 1); PG8_STAGE(PG8_SB(1, 0), b3, voffB); PG8_STAGE(PG8_SB(1, 1), b3 + hstepB, voffB); PG8_STAGE(PG8_SA(1, 0), a3, voffA);
            PG8_WAIT_V(8); PG8_WAIT_L(0); PG8_BAR; PG8_MMA(1, 0, At, B0); PG8_MMA(1, 1, At, B1); PG8_BAR; PG8_SCHED;
        }
        if (wr == 0) PG8_BAR;
        E(acc, cur, wr, wc, fr, fq);
        if (!has_next) break;
#pragma unroll
        for (int a = 0; a < 2; ++a)
#pragma unroll
            for (int b = 0; b < 2; ++b)
#pragma unroll
                for (int m = 0; m < 4; ++m)
#pragma unroll
                    for (int n = 0; n < 2; ++n) acc[a][b][m][n] = (f32x4){0.f, 0.f, 0.f, 0.f};
        cur = nxt; cA = nA; cB = nB; ++ui;
        if (wr == 1) PG8_BAR;
    }
    PG8_WAIT_V(0);
    PG8_BAR;
#undef PG8_SA
#undef PG8_SB
#undef PG8_STAGE
#undef PG8_LDA
#undef PG8_LDB
#undef PG8_MMA
#undef PG8_WAIT_V
#undef PG8_WAIT_L
#undef PG8_BAR
#undef PG8_SCHED
}
}
using pg8::Unit;

__device__ __forceinline__ float row_rs(const GAS float* ssq, int row, int fq) {
    const f32x4 v = *(const GAS f32x4*)(ssq + (size_t)row * 16 + fq * 4);
    float s = (v[0] + v[1]) + (v[2] + v[3]);
    s += __shfl_xor(s, 16); s += __shfl_xor(s, 32);
    return rsqrtf(s * (1.0f / D) + RMS_EPS);
}
__device__ __forceinline__ float silu_mul(float g, float u) { const float e = __builtin_amdgcn_exp2f(-g * 1.4426950408889634f); return g * __builtin_amdgcn_rcpf(1.0f + e) * u; }

constexpr int TAB_OFF_C = 131072;
struct EpiAll {
    int kind;
    GAS void* p0; GAS void* p1; GAS float* ssq; const GAS float* rope; GAS float* out; float alpha;
    LAS unsigned char* ldsb;
    __device__ __forceinline__ bool perm() const { return kind < 3 || kind == 5; }
    template <int NAI, int NM>
    __device__ __forceinline__ void swiglu(const f32x4 (&acc)[2][2][4][2], const Unit& u, int wr, int wc, int fr, int fq) const {
        GAS bf16_t* O = (GAS bf16_t*)p0;
        const int row0 = u.pm * 256 + wr * 64 + fr, col0 = u.pn * 128 + wc * 32 + 8 * fq;
        f32x4 cpv[6]; GAS f32x4* cpd[6];
        if (NAI == 2) {
            constexpr unsigned per_b = (unsigned)(WMAX - 1) * D / 4, full_b = (unsigned)WMAX * D / 4, tot = 2u * NS * per_b;
            const LAS unsigned* t = (const LAS unsigned*)(ldsb + TAB_OFF_C);
            const unsigned long long pk = ((unsigned long long)(unsigned)__builtin_amdgcn_readfirstlane(t[7]) << 32) | (unsigned long long)(unsigned)__builtin_amdgcn_readfirstlane(t[6]);
            const unsigned long long pv = ((unsigned long long)(unsigned)__builtin_amdgcn_readfirstlane(t[9]) << 32) | (unsigned long long)(unsigned)__builtin_amdgcn_readfirstlane(t[8]);
            const GAS f32x4* sk = (const GAS f32x4*)pk; const GAS f32x4* sv = (const GAS f32x4*)pv;
            GAS f32x4* dk = (GAS f32x4*)(out + O_CKS); GAS f32x4* dv = (GAS f32x4*)(out + O_CVS);
            const unsigned Gn = gridDim.x, upw = (128u * 22u + Gn - 1u) / Gn;
            const unsigned chunk = ((unsigned)alpha * upw + (unsigned)u.ui) * Gn + blockIdx.x;
#pragma unroll
            for (int k = 0; k < 6; ++k) { unsigned j = chunk * 3072u + threadIdx.x + 512u * (unsigned)k; const bool ok = j < tot; j = ok ? j : 0u;
                const unsigned ck = j / per_b, r = j - ck * per_b, b = ck >> 1;
                cpv[k] = __builtin_nontemporal_load(((ck & 1) ? sv : sk) + (size_t)b * full_b + (D / 4) + r);
                cpd[k] = ok ? ((ck & 1) ? dv : dk) + (size_t)b * full_b + r : (GAS f32x4*)nullptr; }
        }
#pragma unroll
        for (int ai = 0; ai < NAI; ++ai)
#pragma unroll
            for (int m = 0; m < NM; ++m) {
                const int row = row0 + ai * 128 + m * 16; const float r = row_rs(ssq, row, fq);
                const float r2 = r * r, cneg = r * -1.4426950408889634f;
                float o[8];
#pragma unroll
                for (int n = 0; n < 2; ++n)
#pragma unroll
                    for (int e = 0; e < 4; ++e) { const float g = acc[ai][0][m][n][e], uu = acc[ai][1][m][n][e];
                        o[n * 4 + e] = (g * uu) * r2 * __builtin_amdgcn_rcpf(1.0f + __builtin_amdgcn_exp2f(g * cneg)); }
                u32x4 w; w.x = cvt_pk_bf16(o[0], o[1]); w.y = cvt_pk_bf16(o[2], o[3]); w.z = cvt_pk_bf16(o[4], o[5]); w.w = cvt_pk_bf16(o[6], o[7]);
                *(GAS u32x4*)(O + (size_t)row * FF + col0) = w;
            }
        if (NAI == 2) {
#pragma unroll
            for (int k = 0; k < 6; ++k) if (cpd[k]) __builtin_nontemporal_store(cpv[k], cpd[k]);
        }
    }
    template <bool FINAL, int NAI, int NM>
    __device__ __forceinline__ void res(const f32x4 (&acc)[2][2][4][2], const Unit& u, int wr, int wc, int fr, int fq) const {
        GAS float* X = (GAS float*)p0; GAS bf16_t* XB = (GAS bf16_t*)p1;
        const int row0 = u.pm * 256 + wr * 64 + fr, col0 = u.pn * 256 + wc * 32 + 8 * fq;
#pragma unroll
        for (int ai = 0; ai < NAI; ++ai)
#pragma unroll
            for (int m = 0; m < NM; ++m) {
                const int row = row0 + ai * 128 + m * 16; float ss = 0.f;
#pragma unroll
                for (int bj = 0; bj < 2; ++bj) {
                    GAS bf16_t* px = XB + (size_t)row * D + col0 + bj * 128;
                    const u32x4 ob = *(const GAS u32x4*)px;
                    const f32x4 b0 = (f32x4){__uint_as_float(ob.x << 16), __uint_as_float(ob.x & 0xffff0000u), __uint_as_float(ob.y << 16), __uint_as_float(ob.y & 0xffff0000u)};
                    const f32x4 b1 = (f32x4){__uint_as_float(ob.z << 16), __uint_as_float(ob.z & 0xffff0000u), __uint_as_float(ob.w << 16), __uint_as_float(ob.w & 0xffff0000u)};
                    const f32x4 v0 = b0 + acc[ai][bj][m][0] * alpha, v1 = b1 + acc[ai][bj][m][1] * alpha;
                    ss += (v0[0] * v0[0] + v0[1] * v0[1]) + (v0[2] * v0[2] + v0[3] * v0[3]) + (v1[0] * v1[0] + v1[1] * v1[1]) + (v1[2] * v1[2] + v1[3] * v1[3]);
                    if (FINAL) { GAS float* pf = X + (size_t)row * D + col0 + bj * 128; *(GAS f32x4*)pf = v0; *(GAS f32x4*)(pf + 4) = v1; }
                    else { u32x4 w; w.x = cvt_pk_bf16(v0[0], v0[1]); w.y = cvt_pk_bf16(v0[2], v0[3]); w.z = cvt_pk_bf16(v1[0], v1[1]); w.w = cvt_pk_bf16(v1[2], v1[3]); *(GAS u32x4*)px = w; }
                }
                ss += __shfl_xor(ss, 16); ss += __shfl_xor(ss, 32);
                if (fq == 0) ssq[(size_t)row * 16 + u.pn * 4 + wc] = ss;
            }
    }
    template <int NAI, int NM>
    __device__ __forceinline__ void store(const f32x4 (&acc)[2][2][4][2], const Unit& u, int wr, int wc, int fr, int fq) const {
        GAS bf16_t* O = (GAS bf16_t*)p0;
        const int row0 = u.pm * 256 + wr * 64 + fr, col0 = u.pn * 256 + wc * 32 + 8 * fq;
#pragma unroll
        for (int ai = 0; ai < NAI; ++ai)
#pragma unroll
            for (int m = 0; m < NM; ++m) {
                const int row = row0 + ai * 128 + m * 16;
#pragma unroll
                for (int bj = 0; bj < 2; ++bj) {
                    const f32x4 v0 = acc[ai][bj][m][0], v1 = acc[ai][bj][m][1];
                    u32x4 w; w.x = cvt_pk_bf16(v0[0], v0[1]); w.y = cvt_pk_bf16(v0[2], v0[3]); w.z = cvt_pk_bf16(v1[0], v1[1]); w.w = cvt_pk_bf16(v1[2], v1[3]);
                    *(GAS u32x4*)(O + (size_t)row * D + col0 + bj * 128) = w;
                }
            }
    }
    template <bool ISQ, int NAI, int NM>
    __device__ __forceinline__ void kvq(const f32x4 (&acc)[2][2][4][2], const Unit& u, int wr, int wc, int fr, int fq) const {
        const int row0 = u.pm * 256 + wr * 64 + fr;
        const bool isK = ISQ || u.pn < 4;
        const int colb = (ISQ ? u.pn : (u.pn & 3)) * 256 + wc * 32 + 4 * fq;
        GAS bf16_t* dstb = (GAS bf16_t*)((ISQ || isK) ? p0 : p1);
        const int ldo = ISQ ? NQ : D;
        const bool dorope = isK && wc == 0;
#pragma unroll
        for (int ai = 0; ai < NAI; ++ai)
#pragma unroll
            for (int m = 0; m < NM; ++m) {
                const int row = row0 + ai * 128 + m * 16; const float r = row_rs(ssq, row, fq) * (ISQ ? QSCALE : 1.0f);
                const bool prompt = row < MP;
                const int t = row & (SEQ - 1), b = row >> 13, sb = row - MP;
                const int pidx = prompt ? t : SEQ;
                GAS float* fdst = nullptr;
                if (!ISQ) {
                    if (prompt) { if (t >= SEQ - WMAX) fdst = out + (isK ? O_CKP : O_CVP) + ((size_t)b * WMAX + (t - (SEQ - WMAX))) * D; }
                    else if (sb < NS) fdst = out + (isK ? O_CKS : O_CVS) + ((size_t)sb * WMAX + (WMAX - 1)) * D;
                }
                f32x4 cs = (f32x4){1.f, 1.f, 1.f, 1.f}, sn = (f32x4){0.f, 0.f, 0.f, 0.f};
                if (dorope) { cs = *(const GAS f32x4*)(rope + (size_t)pidx * 32 + 4 * fq); sn = *(const GAS f32x4*)(rope + (size_t)pidx * 32 + 16 + 4 * fq); }
#pragma unroll
                for (int bj = 0; bj < 2; ++bj) {
                    f32x4 v0 = acc[ai][bj][m][0] * r, v1 = acc[ai][bj][m][1] * r;
                    if (dorope) { const f32x4 r1 = v0 * cs - v1 * sn, r2 = v1 * cs + v0 * sn; v0 = r1; v1 = r2; }
                    const int c = colb + bj * 128;
                    u32x2 w0, w1; w0.x = cvt_pk_bf16(v0[0], v0[1]); w0.y = cvt_pk_bf16(v0[2], v0[3]); w1.x = cvt_pk_bf16(v1[0], v1[1]); w1.y = cvt_pk_bf16(v1[2], v1[3]);
                    *(GAS u32x2*)(dstb + (size_t)row * ldo + c) = w0; *(GAS u32x2*)(dstb + (size_t)row * ldo + c + 16) = w1;
                    if (!ISQ) { if (fdst) { *(GAS f32x4*)(fdst + c) = v0; *(GAS f32x4*)(fdst + c + 16) = v1; } }
                }
            }
    }
    template <int NAI, int NM>
    __device__ __forceinline__ void run(const f32x4 (&acc)[2][2][4][2], const Unit& u, int wr, int wc, int fr, int fq) const {
        if (kind == 0) swiglu<NAI, NM>(acc, u, wr, wc, fr, fq);
        else if (kind == 1) res<false, NAI, NM>(acc, u, wr, wc, fr, fq);
        else if (kind == 5) res<true, NAI, NM>(acc, u, wr, wc, fr, fq);
        else if (kind == 2) store<NAI, NM>(acc, u, wr, wc, fr, fq);
        else if (kind == 3) kvq<false, NAI, NM>(acc, u, wr, wc, fr, fq);
        else kvq<true, NAI, NM>(acc, u, wr, wc, fr, fq);
    }
    __device__ __forceinline__ void operator()(const f32x4 (&acc)[2][2][4][2], const Unit& u, int wr, int wc, int fr, int fq) const { run<2, 4>(acc, u, wr, wc, fr, fq); }
};

__device__ __forceinline__ void skinny_item(LAS unsigned char* lds, const pg8::Gemm g, const EpiAll& E, int item) {
    int t_ = threadIdx.x; asm volatile("" : "+v"(t_));
    const int tid = t_, lane = tid & 63, wave = __builtin_amdgcn_readfirstlane(tid >> 6), fr = lane & 15, fq = lane >> 4;
    const int pn = item >> 2, wc = item & 3, K = g.K, ksp = K >> 3, steps = ksp >> 5;
    const bool perm = E.perm();
    const GAS bf16_t* ap[2]; const GAS bf16_t* bp[2][2];
#pragma unroll
    for (int m = 0; m < 2; ++m) ap[m] = g.A + (size_t)(MP + 16 * m + fr) * g.lda + (size_t)pn * g.acol + wave * ksp + 8 * fq;
#pragma unroll
    for (int bj = 0; bj < 2; ++bj)
#pragma unroll
        for (int n = 0; n < 2; ++n) { const int rloc = perm ? (8 * (fr >> 2) + 4 * n + (fr & 3)) : (16 * n + fr);
            bp[bj][n] = g.Bt + (size_t)(256 * pn + 128 * bj + 32 * wc + rloc) * K + wave * ksp + 8 * fq; }
    f32x4 acc[2][2][4][2];
#pragma unroll
    for (int bj = 0; bj < 2; ++bj)
#pragma unroll
        for (int m = 0; m < 2; ++m)
#pragma unroll
            for (int n = 0; n < 2; ++n) acc[0][bj][m][n] = (f32x4){0.f, 0.f, 0.f, 0.f};
#pragma unroll 4
    for (int s = 0; s < steps; ++s) {
        bf16x8 a[2], b[2][2];
#pragma unroll
        for (int m = 0; m < 2; ++m) a[m] = *(const GAS bf16x8*)(ap[m] + 32 * s);
#pragma unroll
        for (int bj = 0; bj < 2; ++bj)
#pragma unroll
            for (int n = 0; n < 2; ++n) b[bj][n] = *(const GAS bf16x8*)(bp[bj][n] + 32 * s);
#pragma unroll
        for (int bj = 0; bj < 2; ++bj)
#pragma unroll
            for (int m = 0; m < 2; ++m)
#pragma unroll
                for (int n = 0; n < 2; ++n) acc[0][bj][m][n] = __builtin_amdgcn_mfma_f32_16x16x32_bf16(b[bj][n], a[m], acc[0][bj][m][n], 0, 0, 0);
    }
    LAS f32x4* red = (LAS f32x4*)lds;
#pragma unroll
    for (int bj = 0; bj < 2; ++bj)
#pragma unroll
        for (int m = 0; m < 2; ++m)
#pragma unroll
            for (int n = 0; n < 2; ++n) red[(wave * 8 + (bj * 4 + m * 2 + n)) * 64 + lane] = acc[0][bj][m][n];
    __syncthreads();
    if (wave == 0) {
#pragma unroll
        for (int bj = 0; bj < 2; ++bj)
#pragma unroll
            for (int m = 0; m < 2; ++m)
#pragma unroll
                for (int n = 0; n < 2; ++n) { f32x4 s = red[(bj * 4 + m * 2 + n) * 64 + lane];
#pragma unroll
                    for (int w = 1; w < 8; ++w) s += red[(w * 8 + (bj * 4 + m * 2 + n)) * 64 + lane];
                    acc[0][bj][m][n] = s; }
        Unit u; u.pm = MP / 256; u.pn = pn; u.ui = 0;
        E.run<1, 2>(acc, u, 0, wc, fr, fq);
    }
    __syncthreads();
}
__device__ __forceinline__ void transpose_item(const float* W, int K, int N, bf16_t* WT, int dst_row0, int k0, int n0, LAS float* scr, int lane, const float* kgain, const float* ngain) {
    { f32x4 v[8];
#pragma unroll
      for (int i = 0; i < 8; ++i) { const int kk = 8 * i + (lane >> 3); v[i] = *(const GAS f32x4*)(W + (size_t)(k0 + kk) * N + n0 + 4 * (lane & 7)); }
#pragma unroll
      for (int i = 0; i < 8; ++i) { const int kk = 8 * i + (lane >> 3); const float kg = kgain ? kgain[k0 + kk] : 1.0f; LAS float* d = scr + kk * 33 + 4 * (lane & 7);
          d[0] = v[i][0] * kg; d[1] = v[i][1] * kg; d[2] = v[i][2] * kg; d[3] = v[i][3] * kg; } }
    asm volatile("s_waitcnt lgkmcnt(0)" ::: "memory");
    const int c = lane & 7;
#pragma unroll
    for (int j = 0; j < 4; ++j) { const int n = (lane >> 3) + 8 * j; const LAS float* s = scr + (8 * c) * 33 + n; const float ng = ngain ? ngain[n0 + n] : 1.0f;
        u32x4 o; o.x = cvt_pk_bf16(s[0 * 33] * ng, s[1 * 33] * ng); o.y = cvt_pk_bf16(s[2 * 33] * ng, s[3 * 33] * ng); o.z = cvt_pk_bf16(s[4 * 33] * ng, s[5 * 33] * ng); o.w = cvt_pk_bf16(s[6 * 33] * ng, s[7 * 33] * ng);
        *(GAS u32x4*)(WT + (size_t)(dst_row0 + n) * K + k0 + 8 * c) = o; }
    asm volatile("s_waitcnt lgkmcnt(0)" ::: "memory");
}
__device__ __forceinline__ void transpose_matrix(const float* W, int K, int N, bf16_t* WT, int mode, const float* kgain, const float* ngain, LAS float* scr, int gw, int NGW, int lane) {
    const int nblk = N / 32, items = (K / 64) * nblk;
    for (int it = gw; it < items; it += NGW) {
        const int kb = it / nblk, nb = it % nblk, k0 = 64 * kb, n0 = 32 * nb;
        int dr = n0;
        if (mode == 1) { if (n0 < FF) dr = 256 * (n0 / 128) + (n0 % 128); else { const int f = n0 - FF; dr = 256 * (f / 128) + 128 + (f % 128); } }
        transpose_item(W, K, N, WT, dr, k0, n0, scr, lane, kgain, ngain);
    }
}
__device__ __forceinline__ void sincos_d(double x, double& s, double& c) {
    const double kq = rint(x * 0.63661977236758134308);
    double r = fma(-kq, 1.57079632679489655800e+00, x); r = fma(-kq, 6.12323399573676603587e-17, r);
    const double r2 = r * r;
    const double sp = r * (1.0 + r2 * (-1.0 / 6 + r2 * (1.0 / 120 + r2 * (-1.0 / 5040 + r2 * (1.0 / 362880 + r2 * (-1.0 / 39916800 + r2 * (1.0 / 6227020800.0 + r2 * (-1.0 / 1307674368000.0))))))));
    const double cp = 1.0 + r2 * (-0.5 + r2 * (1.0 / 24 + r2 * (-1.0 / 720 + r2 * (1.0 / 40320 + r2 * (-1.0 / 3628800 + r2 * (1.0 / 479001600.0 + r2 * (-1.0 / 87178291200.0 + r2 * (1.0 / 20922789888000.0))))))));
    const int q = (int)((long long)kq & 3);
    s = (q == 0) ? sp : (q == 1) ? cp : (q == 2) ? -sp : -cp;
    c = (q == 0) ? cp : (q == 1) ? -sp : (q == 2) ? -cp : sp;
}

__device__ __forceinline__ int kv_off(int row, int ch) { return 256 * row + 16 * (ch ^ (((row & 3) << 2) | ((row >> 2) & 3))); }

#define XB_TMO      128
#define XB_XCNT(j)  (256  + 64 * (j))
#define XB_XSUB(j)  (1280 + 64 * (j))
#define XB_XGEN(j)  (2304 + 64 * (j))
#define XB_TOP      3328
#define XB_TOPGEN   3392
#define XCD_BAR_WORDS 3456
#define XB_SPIN_CAP (1u << 18)

__device__ __forceinline__ unsigned xb_ld(unsigned* p)              { return __hip_atomic_load(p, __ATOMIC_RELAXED, __HIP_MEMORY_SCOPE_AGENT); }
__device__ __forceinline__ unsigned xb_add(unsigned* p, unsigned v) { return __hip_atomic_fetch_add(p, v, __ATOMIC_RELAXED, __HIP_MEMORY_SCOPE_AGENT); }
__device__ __forceinline__ unsigned xb_xcc_id() { return (unsigned)__builtin_amdgcn_s_getreg((3 << 11) | 20) & 0xFu; }
#define XB_SPIN(cond, bar) do { unsigned _sp = 0; while (cond) { __builtin_amdgcn_s_sleep(1); \
    if ((++_sp & 255u) == 0u) { if (xb_ld(&(bar)[XB_TMO])) break; if (_sp > XB_SPIN_CAP) { atomicAdd(&(bar)[XB_TMO], 1u); break; } } } } while (0)

struct XcdBarrier {
    unsigned* bar; unsigned x;
    volatile LAS unsigned* st;
};

__device__ __forceinline__ XcdBarrier xcd_barrier_post(unsigned* bar, volatile LAS unsigned* st) {
    XcdBarrier b; b.bar = bar; b.x = xb_xcc_id(); b.st = st;
    if (threadIdx.x == 0) (void)xb_add(&bar[XB_XCNT(b.x)], 1u);
    return b;
}
__device__ __forceinline__ void xcd_barrier_complete(unsigned* bar, unsigned x, unsigned& nloc, unsigned& nx) {
    const unsigned G = gridDim.x * gridDim.y * gridDim.z;
    unsigned sum, cnt, mine, sp = 0u;
    for (;;) {
        sum = 0u; cnt = 0u; mine = 0u;
#pragma unroll
        for (unsigned j = 0; j < 16; ++j) { const unsigned c = xb_ld(&bar[XB_XCNT(j)]); sum += c; cnt += (c > 0u) ? 1u : 0u; mine = (j == x) ? c : mine; }
        if (sum == G) break;
        __builtin_amdgcn_s_sleep(1);
        if ((++sp & 255u) == 0u) { if (xb_ld(&bar[XB_TMO])) break; if (sp > XB_SPIN_CAP) { atomicAdd(&bar[XB_TMO], 1u); break; } }
    }
    nloc = mine > 0u ? mine : 1u; nx = cnt > 0u ? cnt : 1u;
}

__device__ __forceinline__ void xcd_barrier(const XcdBarrier& b) {
    asm volatile("s_waitcnt vmcnt(0)" ::: "memory");
    __syncthreads();
    if (threadIdx.x == 0) {
        unsigned* bar = b.bar;
        __builtin_amdgcn_s_waitcnt(0);
        unsigned nloc = b.st[0], nx = b.st[1];
        if (nloc == 0u) { xcd_barrier_complete(bar, b.x, nloc, nx); b.st[0] = nloc; b.st[1] = nx; }
        const unsigned old = xb_add(&bar[XB_XSUB(b.x)], 1u);
        const unsigned gen = old / nloc;
        if (old + 1u == (gen + 1u) * nloc) {
            __builtin_amdgcn_fence(__ATOMIC_RELEASE, "agent");
            asm volatile("s_waitcnt vmcnt(0)" ::: "memory");
            const unsigned og = xb_add(&bar[XB_TOP], 1u);
            const unsigned tg = og / nx;
            if (og + 1u == (tg + 1u) * nx) xb_add(&bar[XB_TOPGEN], 1u);
            else XB_SPIN(xb_ld(&bar[XB_TOPGEN]) == tg, bar);
            __builtin_amdgcn_fence(__ATOMIC_ACQUIRE, "agent");
            xb_add(&bar[XB_XGEN(b.x)], 1u);
            asm volatile("s_waitcnt vmcnt(0)" ::: "memory");
        } else {
            XB_SPIN(xb_ld(&bar[XB_XGEN(b.x)]) == gen, bar);
            __builtin_amdgcn_fence(__ATOMIC_ACQUIRE, "agent");
            asm volatile("s_waitcnt vmcnt(0)" ::: "memory");
        }
    }
    __syncthreads();
}

constexpr int TAB_OFF = 131072;
struct GD { unsigned long long A, Bt, p0, p1; int N, K, lda, acol, kind, sync; float alpha; int pad; };
constexpr int NGEMM = 13;
__device__ __forceinline__ GAS unsigned char* ldp(LAS unsigned char* lds, int i) {
    const LAS unsigned* t = (const LAS unsigned*)(lds + TAB_OFF) + 2 * i;
    const unsigned lo = __builtin_amdgcn_readfirstlane(t[0]), hi = __builtin_amdgcn_readfirstlane(t[1]);
    return (GAS unsigned char*)(((unsigned long long)hi << 32) | lo);
}

#define XBAR_ST_OFF (TAB_OFF + 2048)
#define GRID_BAR() do { XcdBarrier b_; b_.bar = (unsigned*)ldp(lds, 21); b_.x = xb_xcc_id(); b_.st = (volatile LAS unsigned*)(lds + XBAR_ST_OFF); xcd_barrier(b_); } while (0)
__global__ void __launch_bounds__(512, 2) yoco_fwd(Params P) {
    extern __shared__ __attribute__((aligned(16))) unsigned char lds_raw[];
    LAS unsigned char* lds = (LAS unsigned char*)lds_raw;
    cg::grid_group grid = cg::this_grid();
    const int tid = threadIdx.x, lane = tid & 63, wave = __builtin_amdgcn_readfirstlane(tid >> 6);
    const int G = gridDim.x, bx = blockIdx.x;
    const size_t WIN_E = (size_t)2 * FF * D, WOUT_E = (size_t)D * FF;

    if (tid == 0) { ((volatile LAS unsigned*)(lds + XBAR_ST_OFF))[0] = 0u; ((volatile LAS unsigned*)(lds + XBAR_ST_OFF))[1] = 0u; }
    (void)xcd_barrier_post((unsigned*)P.ws, (volatile LAS unsigned*)(lds + XBAR_ST_OFF));
    if (tid == 0) {
        LAS unsigned long long* pt = (LAS unsigned long long*)(lds + TAB_OFF);
#define PT(i) pt[i] = (unsigned long long)P.in[i]
        PT(0); PT(1); PT(2); PT(3); PT(4); PT(5); PT(6); PT(7); PT(8); PT(9); PT(10); PT(11); PT(12); PT(13); PT(14); PT(15); PT(16); PT(17); PT(18); PT(19);
#undef PT
        pt[20] = (unsigned long long)P.out; pt[21] = (unsigned long long)P.ws;
        const unsigned long long w = (unsigned long long)P.ws;
        LAS GD* gd = (LAS GD*)(lds + TAB_OFF + 256);
        const unsigned long long XBp = w + WS_XB, ACTp = w + WS_ACT, XFp = w + WS_XF, PBp = w + WS_PB, ZBp = w + WS_ZB;
#define SETG(i, A_, B_, P0_, P1_, N_, K_, LDA_, AC_, KIND_, SYNC_, AL_) do { LAS unsigned long long* q_ = (LAS unsigned long long*)(gd + (i)); q_[0] = (A_); q_[1] = (B_); q_[2] = (P0_); q_[3] = (P1_); LAS int* r_ = (LAS int*)(q_ + 4); r_[0] = (N_); r_[1] = (K_); r_[2] = (LDA_); r_[3] = (AC_); r_[4] = (KIND_); r_[5] = (SYNC_); ((LAS float*)r_)[6] = (AL_); r_[7] = 0; } while (0)
        SETG(0, XBp, w + WS_WIN, ACTp, 0ull, 2 * FF, D, D, 0, 0, 1, 0.f);
        SETG(1, ACTp, w + WS_WOUT, XFp, XBp, D, FF, FF, 0, 1, 1, 0.5f);
        SETG(2, PBp, w + WS_WPG, ZBp, 0ull, D, 256, D, 256, 2, 1, 0.f);
        SETG(3, ZBp, w + WS_WPO, XFp, XBp, D, D, D, 0, 1, 1, 1.0f);
        SETG(4, XBp, w + WS_WIN + WIN_BYTES, ACTp, 0ull, 2 * FF, D, D, 0, 0, 1, 1.f);
        SETG(5, ACTp, w + WS_WOUT + WOUT_BYTES, XFp, XBp, D, FF, FF, 0, 1, 1, 0.5f);
        SETG(6, XBp, w + WS_WKV, w + WS_KB, w + WS_VB, 2 * D, D, D, 0, 3, 0, 0.f);
        SETG(7, XBp, w + WS_WIN + 2 * WIN_BYTES, ACTp, 0ull, 2 * FF, D, D, 0, 0, 1, 2.f);
        SETG(8, ACTp, w + WS_WOUT + 2 * WOUT_BYTES, XFp, XBp, D, FF, FF, 0, 1, 1, 0.5f);
        SETG(9, XBp, w + WS_WQ, w + WS_QB, 0ull, NQ, D, D, 0, 4, 1, 0.f);
        SETG(10, PBp, w + WS_WO, XFp, XBp, D, D, D, 0, 1, 1, 1.0f);
        SETG(11, XBp, w + WS_WIN + 3 * WIN_BYTES, ACTp, 0ull, 2 * FF, D, D, 0, 0, 1, 3.f);
        SETG(12, ACTp, w + WS_WOUT + 3 * WOUT_BYTES, XFp, XBp, D, FF, FF, 0, 1, 1, 0.5f);
#undef SETG
    }
    __syncthreads();

    {
        const int gw = bx * 8 + wave, NGW = G * 8;
        const size_t gtid = (size_t)bx * 512 + tid, GT = (size_t)G * 512;
        GAS unsigned char* ws = (GAS unsigned char*)P.ws;
        GAS bf16_t* Win = (GAS bf16_t*)(ws + WS_WIN); GAS bf16_t* Wout = (GAS bf16_t*)(ws + WS_WOUT); GAS bf16_t* Wpg = (GAS bf16_t*)(ws + WS_WPG);
        LAS float* scr = (LAS float*)(lds + wave * 16384);
        transpose_matrix(P.in[6], D, 2 * FF, Win, 1, P.in[5], nullptr, scr, gw, NGW, lane);
        transpose_matrix(P.in[10], D, 2 * FF, Win + WIN_E, 1, P.in[9], nullptr, scr, gw, NGW, lane);
        transpose_matrix(P.in[6] + WIN_E, D, 2 * FF, Win + 2 * WIN_E, 1, P.in[5] + D, nullptr, scr, gw, NGW, lane);
        transpose_matrix(P.in[10] + WIN_E, D, 2 * FF, Win + 3 * WIN_E, 1, P.in[9] + D, nullptr, scr, gw, NGW, lane);
        transpose_matrix(P.in[7], FF, D, Wout, 0, nullptr, nullptr, scr, gw, NGW, lane);
        transpose_matrix(P.in[11], FF, D, Wout + WOUT_E, 0, nullptr, nullptr, scr, gw, NGW, lane);
        transpose_matrix(P.in[7] + WOUT_E, FF, D, Wout + 2 * WOUT_E, 0, nullptr, nullptr, scr, gw, NGW, lane);
        transpose_matrix(P.in[11] + WOUT_E, FF, D, Wout + 3 * WOUT_E, 0, nullptr, nullptr, scr, gw, NGW, lane);
        for (int gi = 0; gi < 4; ++gi) transpose_matrix(P.in[12] + (size_t)gi * 65536, 256, 256, Wpg + (size_t)gi * 65536, 0, nullptr, P.in[13] + gi * 256, scr, gw, NGW, lane);
        transpose_matrix(P.in[14], D, D, (GAS bf16_t*)(ws + WS_WPO), 0, nullptr, nullptr, scr, gw, NGW, lane);
        transpose_matrix(P.in[16], D, 2 * D, (GAS bf16_t*)(ws + WS_WKV), 0, P.in[15], nullptr, scr, gw, NGW, lane);
        transpose_matrix(P.in[17], D, NQ, (GAS bf16_t*)(ws + WS_WQ), 0, P.in[8] + D, nullptr, scr, gw, NGW, lane);
        transpose_matrix(P.in[18], D, D, (GAS bf16_t*)(ws + WS_WO), 0, nullptr, nullptr, scr, gw, NGW, lane);
        {
            const GAS float* x_prompt = (const GAS float*)P.in[0]; const GAS float* x_sample = (const GAS float*)P.in[1];
            GAS bf16_t* XB = (GAS bf16_t*)(ws + WS_XB); GAS float* ssq = (GAS float*)(ws + WS_SSQ);
            for (int row0 = gw; row0 < MV; row0 += 4 * NGW) {
                f32x4 v[4][4];
#pragma unroll
                for (int q = 0; q < 4; ++q) { const int row = row0 + q * NGW; const int rc = row < MV ? row : MV - 1;
                    const GAS f32x4* xr = (const GAS f32x4*)(rc < MP ? x_prompt + (size_t)rc * D : x_sample + (size_t)(rc - MP) * D) + lane;
#pragma unroll
                    for (int j = 0; j < 4; ++j) v[q][j] = xr[64 * j]; }
#pragma unroll
                for (int q = 0; q < 4; ++q) { const int row = row0 + q * NGW;
                    float s = 0.f;
#pragma unroll
                    for (int j = 0; j < 4; ++j) s += (v[q][j][0] * v[q][j][0] + v[q][j][1] * v[q][j][1]) + (v[q][j][2] * v[q][j][2] + v[q][j][3] * v[q][j][3]);
                    s = wave_sum(s);
                    if (row < MV) {
                        GAS u32x2* bo = (GAS u32x2*)(XB + (size_t)row * D) + lane;
#pragma unroll
                        for (int j = 0; j < 4; ++j) { u32x2 w; w.x = cvt_pk_bf16(v[q][j][0], v[q][j][1]); w.y = cvt_pk_bf16(v[q][j][2], v[q][j][3]); bo[64 * j] = w; }
                        if (lane < 16) ssq[(size_t)row * 16 + lane] = lane == 0 ? s : 0.f;
                    }
                }
            }
        }
        {
            GAS float* rope = (GAS float*)(ws + WS_ROPE);
            for (size_t i = gtid; i < (size_t)(SEQ + 1) * 16; i += GT) {
                const int pi = (int)(i >> 4), fi = (int)(i & 15); const double pos = pi < SEQ ? (double)pi : 16384.0;
                double iv = P.invf[0];
#define IV(k) if (fi == k) iv = P.invf[k]
                IV(1); IV(2); IV(3); IV(4); IV(5); IV(6); IV(7); IV(8); IV(9); IV(10); IV(11); IV(12); IV(13); IV(14); IV(15);
#undef IV
                double s, c; sincos_d(pos * iv, s, c);
                rope[(size_t)pi * 32 + fi] = (float)c; rope[(size_t)pi * 32 + 16 + fi] = (float)s;
            }
        }
    }
    if (G == 0x7fffffff) grid.sync();
    GRID_BAR();

    for (int gi = 0; gi < NGEMM; ++gi) {
        if (gi == 2) {
            int t_ = threadIdx.x; asm volatile("" : "+v"(t_)); const int tid = t_, lane = tid & 63, wave = __builtin_amdgcn_readfirstlane(tid >> 6); (void)lane; (void)wave;
            GAS unsigned char* ws = ldp(lds, 21); GAS float* out = (GAS float*)ldp(lds, 20);
            const GAS float* mix_norm = (const GAS float*)ldp(lds, 8); const GAS float* state_pool = (const GAS float*)ldp(lds, 2);
            const GAS float* ssq = (const GAS float*)(ws + WS_SSQ); const GAS bf16_t* XB = (const GAS bf16_t*)(ws + WS_XB); GAS bf16_t* PBUF = (GAS bf16_t*)(ws + WS_PB);
#define LDH(r_) ({ const u32x2 q_ = *(const GAS u32x2*)(XB + (size_t)(r_) * D + 4 * cq); (f32x4){__uint_as_float(q_.x << 16), __uint_as_float(q_.x & 0xffff0000u), __uint_as_float(q_.y << 16), __uint_as_float(q_.y & 0xffff0000u)}; })
            LAS float* rr = (LAS float*)lds;
            for (int unit = bx; unit < MP / 64 + NS; unit += G) {
                __syncthreads();
                if (unit < MP / 64) {
                    const int R0 = unit * 64, b = R0 >> 13, t0 = R0 & (SEQ - 1);
                    if (tid < 80) { const int tt = tid - 16; float r = 0.f;
                        if (t0 + tt >= 0) { const GAS float* sp = ssq + (size_t)(R0 + tt) * 16; float s = 0.f;
#pragma unroll
                            for (int j = 0; j < 16; ++j) s += sp[j];
                            r = rsqrtf(s * (1.0f / D) + RMS_EPS); }
                        rr[tid] = r; }
                    __syncthreads();
                    const int cq = tid & 255, half = tid >> 8, gq = cq >> 6, w = 2 << gq;
                    const f32x4 gm = *(const GAS f32x4*)(mix_norm + 4 * cq);
                    const int s0 = half * 32;
                    f32x4 win = (f32x4){0.f, 0.f, 0.f, 0.f};
#define LDRAW(r_) (*(const GAS u32x2*)(XB + (size_t)(r_) * D + 4 * cq))
#define UNP2(q_) ((f32x4){__uint_as_float((q_).x << 16), __uint_as_float((q_).x & 0xffff0000u), __uint_as_float((q_).y << 16), __uint_as_float((q_).y & 0xffff0000u)})
                    {
                        u32x2 hv[15];
#pragma unroll
                        for (int i = 1; i < 16; ++i) { const int tt = s0 - i; hv[i - 1] = (i < w && t0 + tt >= 0) ? LDRAW(R0 + tt) : (u32x2){0u, 0u}; }
#pragma unroll
                        for (int i = 1; i < 16; ++i) { const int tt = s0 - i; if (i < w && t0 + tt >= 0) win += UNP2(hv[i - 1]) * rr[tt + 16] * gm; }
                    }
                    for (int tb = s0; tb < s0 + 32; tb += 8) {
                        u32x2 cv[8], ov[8];
#pragma unroll
                        for (int k = 0; k < 8; ++k) { cv[k] = LDRAW(R0 + tb + k); const int to = tb + k - w + 1; ov[k] = (t0 + to >= 0) ? LDRAW(R0 + to) : (u32x2){0u, 0u}; }
#pragma unroll
                        for (int k = 0; k < 8; ++k) { const int tt = tb + k;
                            const f32x4 hc = UNP2(cv[k]) * rr[tt + 16] * gm;
                            win += hc;
                            const int t = t0 + tt; const float inv = 1.0f / (float)(t + 1 < w ? t + 1 : w);
                            const f32x4 p = win * inv - hc;
                            u32x2 o; o.x = cvt_pk_bf16(p[0], p[1]); o.y = cvt_pk_bf16(p[2], p[3]);
                            *(GAS u32x2*)(PBUF + (size_t)(R0 + tt) * D + 4 * cq) = o;
                            if (t >= SEQ - PB) *(GAS f32x4*)(out + O_SPP + ((size_t)b * PB + (t - (SEQ - PB))) * D + 4 * cq) = hc;
                            const int to = tt - w + 1; if (t0 + to >= 0) win -= UNP2(ov[k]) * rr[to + 16] * gm; }
                    }
#undef UNP2
#undef LDRAW
                } else {
                    const int sb = unit - MP / 64, row = MP + sb;
                    if (tid < 256) {
                        const int cq = tid, gq = cq >> 6, w = 2 << gq;
                        const GAS float* sp = ssq + (size_t)row * 16; float s = 0.f;
#pragma unroll
                        for (int j = 0; j < 16; ++j) s += sp[j];
                        const float r = rsqrtf(s * (1.0f / D) + RMS_EPS);
                        const f32x4 gm = *(const GAS f32x4*)(mix_norm + 4 * cq);
                        const f32x4 hn = LDH(row) * r * gm;
                        f32x4 win = hn;
                        for (int i = 0; i < PB; ++i) {
                            const f32x4 pv = *(const GAS f32x4*)(state_pool + ((size_t)sb * PB + i) * D + 4 * cq);
                            if (i >= PB - (w - 1)) win += pv;
                            if (i >= 1) *(GAS f32x4*)(out + O_SPS + ((size_t)sb * PB + (i - 1)) * D + 4 * cq) = pv;
                        }
                        *(GAS f32x4*)(out + O_SPS + ((size_t)sb * PB + (PB - 1)) * D + 4 * cq) = hn;
                        const f32x4 p = win * (1.0f / (float)w) - hn;
                        u32x2 o; o.x = cvt_pk_bf16(p[0], p[1]); o.y = cvt_pk_bf16(p[2], p[3]);
                        *(GAS u32x2*)(PBUF + (size_t)row * D + 4 * cq) = o;
                    }
                }
            }
            GRID_BAR();
        }
        if (gi == 10) {
            {
                int t_ = threadIdx.x; asm volatile("" : "+v"(t_)); const int tid = t_, lane = tid & 63, wave = __builtin_amdgcn_readfirstlane(tid >> 6);
                GAS unsigned char* ws = ldp(lds, 21);
                const GAS bf16_t* KB = (const GAS bf16_t*)(ws + WS_KB); const GAS bf16_t* VB = (const GAS bf16_t*)(ws + WS_VB); const GAS bf16_t* QB = (const GAS bf16_t*)(ws + WS_QB);
                GAS bf16_t* OG = (GAS bf16_t*)(ws + WS_OG); GAS float* lse = (GAS float*)(ws + WS_LSE);
                const int qi = lane & 15, qd = lane >> 4;
                const int per = (6144 + G - 1) / G, u0 = bx * per, u1 = (u0 + per < 6144) ? u0 + per : 6144;
                u32x4 kr[4], vr[4]; bf16x8 qn[4];
#define DEC(u_, gq_, b_, h_, cls_, n_, dl_) const int gq_ = (u_) / 2048, b_ = ((u_) >> 9) & 3, h_ = ((u_) >> 6) & 7, blk_##u_ = (u_) & 63; const int dl_ = gq_ == 0 ? 1 : (gq_ == 1 ? 4 : 16); const int nbk_##u_ = 64 / dl_, cls_ = blk_##u_ / nbk_##u_, n_ = blk_##u_ % nbk_##u_
#define ISSUE(gq_, b_, h_, cls_, n_, dl_) do { \
                    _Pragma("unroll") for (int i = 0; i < 4; ++i) { const int c = tid + 512 * i, row = c >> 4, ch = c & 15; \
                        const size_t so = ((size_t)(b_) * SEQ + (size_t)((128 * (n_) + row) * (dl_) + (cls_))) * D + (h_) * HD + ch * 8; kr[i] = *(const GAS u32x4*)(KB + so); vr[i] = *(const GAS u32x4*)(VB + so); } \
                    { const size_t qrow_ = (size_t)(b_) * SEQ + (size_t)((128 * (n_) + 16 * wave + qi) * (dl_) + (cls_)); \
                      _Pragma("unroll") for (int s = 0; s < 4; ++s) qn[s] = *(const GAS bf16x8*)(QB + qrow_ * NQ + ((gq_) * 8 + (h_)) * HD + 32 * s + 8 * qd); } } while (0)
                int rot = 0; bool chained = false;
                { const int uu = u0 < 6144 ? u0 : 6143; DEC(uu, g0, b0, h0, c0, n0, d0); ISSUE(g0, b0, h0, c0, n0, d0); }
                for (int u = u0; u < u1; ++u) {
                    DEC(u, gq, b, h, cls, n, dl);
                    __syncthreads();
                    {
                        const unsigned rx = (unsigned)rot << 15;
#pragma unroll
                        for (int i = 0; i < 4; ++i) { const int c = tid + 512 * i, row = c >> 4, ch = c & 15;
                            const unsigned oo = (unsigned)kv_off(128 + row, ch) ^ rx; *(LAS u32x4*)(lds + oo) = kr[i]; *(LAS u32x4*)(lds + 65536 + oo) = vr[i];
                        }
                        if (!chained) {
#pragma unroll
                            for (int i = 0; i < 4; ++i) { const int c = tid + 512 * i, row = c >> 4, ch = c & 15;
                                u32x4 kp = (u32x4){0u, 0u, 0u, 0u}, vp = (u32x4){0u, 0u, 0u, 0u};
                                if (n > 0) { const size_t sp = ((size_t)b * SEQ + (size_t)((128 * (n - 1) + row) * dl + cls)) * D + h * HD + ch * 8; kp = *(const GAS u32x4*)(KB + sp); vp = *(const GAS u32x4*)(VB + sp); }
                                const unsigned op = (unsigned)kv_off(row, ch) ^ rx; *(LAS u32x4*)(lds + op) = kp; *(LAS u32x4*)(lds + 65536 + op) = vp; }
                        }
                    }
                    bf16x8 qf[4];
#pragma unroll
                    for (int s = 0; s < 4; ++s) qf[s] = qn[s];
                    __syncthreads();
                    const int rotc = rot;
                    { const int un = (u + 1 < u1) ? u + 1 : u;
                      DEC(un, g1, b1, h1, c1, n1, d1); const bool ch1 = (n1 != 0) && ((un & 63) != 0) && (un != u);
                      ISSUE(g1, b1, h1, c1, n1, d1);
                      chained = ch1; rot = ch1 ? (rot ^ 1) : 0; }
                    const unsigned rx = (unsigned)rotc << 15;
                    const int ii = 16 * wave + qi; const size_t qrow = (size_t)b * SEQ + (size_t)((128 * n + ii) * dl + cls);
                    const int kw = 16 * wave;
                    f32x4 Sx[9];
                    {
                        bf16x8 kf[2][4];
#pragma unroll
                        for (int s = 0; s < 4; ++s) kf[0][s] = *(const LAS bf16x8*)(lds + ((unsigned)kv_off(kw + qi, 4 * s + qd) ^ rx));
#pragma unroll
                        for (int j = 0; j < 9; ++j) {
                            if (j < 8) {
#pragma unroll
                                for (int s = 0; s < 4; ++s) kf[(j + 1) & 1][s] = *(const LAS bf16x8*)(lds + ((unsigned)kv_off(kw + 16 * (j + 1) + qi, 4 * s + qd) ^ rx));
                            }
                            f32x4 a = (f32x4){0.f, 0.f, 0.f, 0.f};
#pragma unroll
                            for (int s = 0; s < 4; ++s) a = __builtin_amdgcn_mfma_f32_16x16x32_bf16(kf[j & 1][s], qf[s], a, 0, 0, 0);
                            if (j == 0) {
#pragma unroll
                                for (int e = 0; e < 4; ++e) a[e] = (4 * qd + e >= qi) ? a[e] : -INFINITY; }
                            if (j == 8) {
#pragma unroll
                                for (int e = 0; e < 4; ++e) a[e] = (4 * qd + e <= qi) ? a[e] : -INFINITY; }
                            Sx[j] = a;
                        }
                    }
                    if (n == 0) {
#pragma unroll
                        for (int j = 0; j < 8; ++j) if (wave + j < 8) Sx[j] = (f32x4){-INFINITY, -INFINITY, -INFINITY, -INFINITY};
                    }
                    float mx = -INFINITY;
#pragma unroll
                    for (int kt = 0; kt < 9; ++kt) mx = fmaxf(mx, fmaxf(fmaxf(Sx[kt][0], Sx[kt][1]), fmaxf(Sx[kt][2], Sx[kt][3])));
                    mx = fmaxf(mx, __shfl_xor(mx, 16)); mx = fmaxf(mx, __shfl_xor(mx, 32));
                    float ls = 0.f;
#pragma unroll
                    for (int kt = 0; kt < 9; ++kt)
#pragma unroll
                        for (int e = 0; e < 4; ++e) { const float p = __builtin_amdgcn_exp2f(Sx[kt][e] - mx); Sx[kt][e] = p; ls += p; }
                    ls += __shfl_xor(ls, 16); ls += __shfl_xor(ls, 32);
                    f32x4 O[8];
#pragma unroll
                    for (int dt = 0; dt < 8; ++dt) O[dt] = (f32x4){0.f, 0.f, 0.f, 0.f};
                    const int q4 = qi >> 2, p4 = qi & 3, sw = (q4 << 2) | qd;
                    const unsigned vlane = 65536u + 256u * (unsigned)(4 * qd + q4) + 8u * (unsigned)(p4 & 1);
#define TRR(dst, addr) asm volatile("ds_read_b64_tr_b16 %0, %1" : "=&v"(dst) : "v"(addr) : "memory")
#define TRBATCH(i_, L_, H_) do { const int ks_ = (i_) >> 1, dh_ = (i_) & 1; const int tl_ = 2 * ks_, th_ = (2 * ks_ + 1 < 9) ? 2 * ks_ + 1 : 8; \
                        const unsigned blo_ = ((256u * (unsigned)(kw + 16 * tl_)) ^ rx) + vlane, bhi_ = ((256u * (unsigned)(kw + 16 * th_)) ^ rx) + vlane; \
                        _Pragma("unroll") for (int d4 = 0; d4 < 4; ++d4) { const int dt_ = 4 * dh_ + d4; const unsigned co_ = 16u * (unsigned)((2 * dt_ + (p4 >> 1)) ^ sw); const unsigned a0_ = blo_ + co_, a1_ = bhi_ + co_; TRR(L_[d4], a0_); TRR(H_[d4], a1_); } } while (0)
#define PVMMA(i_, L_, H_) do { const int ks_ = (i_) >> 1, dh_ = (i_) & 1; \
                        bf16x8 pf_; { u32x4 t_; t_.x = cvt_pk_bf16(Sx[2 * ks_][0], Sx[2 * ks_][1]); t_.y = cvt_pk_bf16(Sx[2 * ks_][2], Sx[2 * ks_][3]); \
                            if (2 * ks_ + 1 < 9) { t_.z = cvt_pk_bf16(Sx[(2 * ks_ + 1 < 9) ? 2 * ks_ + 1 : 8][0], Sx[(2 * ks_ + 1 < 9) ? 2 * ks_ + 1 : 8][1]); t_.w = cvt_pk_bf16(Sx[(2 * ks_ + 1 < 9) ? 2 * ks_ + 1 : 8][2], Sx[(2 * ks_ + 1 < 9) ? 2 * ks_ + 1 : 8][3]); } else { t_.z = 0u; t_.w = 0u; } \
                            pf_ = __builtin_bit_cast(bf16x8, t_); } \
                        _Pragma("unroll") for (int d4 = 0; d4 < 4; ++d4) { const int dt_ = 4 * dh_ + d4; const bf16x8 vf_ = (bf16x8){L_[d4][0], L_[d4][1], L_[d4][2], L_[d4][3], H_[d4][0], H_[d4][1], H_[d4][2], H_[d4][3]}; \
                            O[dt_] = __builtin_amdgcn_mfma_f32_16x16x32_bf16(vf_, pf_, O[dt_], 0, 0, 0); } } while (0)
#define TRWAIT(cnt_, L_, H_) asm volatile("s_waitcnt lgkmcnt(" #cnt_ ")" : "+v"(L_[0]), "+v"(L_[1]), "+v"(L_[2]), "+v"(L_[3]), "+v"(H_[0]), "+v"(H_[1]), "+v"(H_[2]), "+v"(H_[3]) :: "memory")
                    {
                        s16x4 la[4], ha[4], lb[4], hb[4];
                        TRBATCH(0, la, ha);
                        TRBATCH(1, lb, hb); TRWAIT(8, la, ha); PVMMA(0, la, ha);
                        TRBATCH(2, la, ha); TRWAIT(8, lb, hb); PVMMA(1, lb, hb);
                        TRBATCH(3, lb, hb); TRWAIT(8, la, ha); PVMMA(2, la, ha);
                        TRBATCH(4, la, ha); TRWAIT(8, lb, hb); PVMMA(3, lb, hb);
                        TRBATCH(5, lb, hb); TRWAIT(8, la, ha); PVMMA(4, la, ha);
                        TRBATCH(6, la, ha); TRWAIT(8, lb, hb); PVMMA(5, lb, hb);
                        TRBATCH(7, lb, hb); TRWAIT(8, la, ha); PVMMA(6, la, ha);
                        TRBATCH(8, la, ha); TRWAIT(8, lb, hb); PVMMA(7, lb, hb);
                        TRBATCH(9, lb, hb); TRWAIT(8, la, ha); PVMMA(8, la, ha);
                        TRWAIT(0, lb, hb); PVMMA(9, lb, hb);
                    }
#undef TRWAIT
#undef PVMMA
#undef TRBATCH
#undef TRR
                    const float inv = 1.0f / ls;
                    GAS bf16_t* od = OG + ((size_t)gq * MT + qrow) * D + h * HD + 4 * qd;
#pragma unroll
                    for (int dt = 0; dt < 8; ++dt) { u32x2 w; w.x = cvt_pk_bf16(O[dt][0] * inv, O[dt][1] * inv); w.y = cvt_pk_bf16(O[dt][2] * inv, O[dt][3] * inv); *(GAS u32x2*)(od + 16 * dt) = w; }
                    if (qd == 0) lse[((size_t)gq * MT + qrow) * 8 + h] = mx + __builtin_amdgcn_logf(ls);
                }
#undef ISSUE
#undef DEC
            }
            {
                int t_ = threadIdx.x; asm volatile("" : "+v"(t_)); const int tid = t_, lane = tid & 63, wave = __builtin_amdgcn_readfirstlane(tid >> 6);
                GAS unsigned char* ws = ldp(lds, 21); const GAS float* out = (const GAS float*)ldp(lds, 20);
                const GAS float* cache_k = (const GAS float*)ldp(lds, 3); const GAS float* cache_v = (const GAS float*)ldp(lds, 4);
                const GAS bf16_t* QB = (const GAS bf16_t*)(ws + WS_QB); GAS bf16_t* PBUF = (GAS bf16_t*)(ws + WS_PB);
                LAS float* sc = (LAS float*)lds;
                LAS f32x4* red = (LAS f32x4*)(lds + 2048);
                for (int unit = bx; unit < NS * NH; unit += G) {
                    const int b = unit >> 3, h = unit & 7;
                    __syncthreads();
                    const int l16 = lane & 15, kq = lane >> 4;
#pragma unroll
                    for (int pass = 0; pass < 13; ++pass) {
                        const int pi = pass * 32 + wave * 4 + kq, pc = pi < 387 ? pi : 386;
                        const int gq = pc / 129, j = pc % 129, dl = gq == 0 ? 1 : (gq == 1 ? 4 : 16);
                        const GAS float* kp = (j == 0) ? out + O_CKS + ((size_t)b * WMAX + (WMAX - 1)) * D : cache_k + ((size_t)b * WMAX + (WMAX - dl * j)) * D;
                        const f32x4 k0 = *(const GAS f32x4*)(kp + h * HD + 8 * l16), k1 = *(const GAS f32x4*)(kp + h * HD + 8 * l16 + 4);
                        const u32x4 qv = *(const GAS u32x4*)(QB + (size_t)(MP + b) * NQ + (gq * 8 + h) * HD + 8 * l16);
                        float s = k0[0] * __uint_as_float(qv.x << 16) + k0[1] * __uint_as_float(qv.x & 0xffff0000u) + k0[2] * __uint_as_float(qv.y << 16) + k0[3] * __uint_as_float(qv.y & 0xffff0000u)
                                + k1[0] * __uint_as_float(qv.z << 16) + k1[1] * __uint_as_float(qv.z & 0xffff0000u) + k1[2] * __uint_as_float(qv.w << 16) + k1[3] * __uint_as_float(qv.w & 0xffff0000u);
                        s += __shfl_xor(s, 1); s += __shfl_xor(s, 2); s += __shfl_xor(s, 4); s += __shfl_xor(s, 8);
                        if (l16 == 0 && pi < 387) sc[pi] = s;
                    }
                    __syncthreads();
                    if (wave == 0) {
                        float v[7]; float mx = -INFINITY;
#pragma unroll
                        for (int i = 0; i < 7; ++i) { const int pi = lane + 64 * i; v[i] = pi < 387 ? sc[pi] : -INFINITY; mx = fmaxf(mx, v[i]); }
                        mx = wave_max(mx); float ls = 0.f;
#pragma unroll
                        for (int i = 0; i < 7; ++i) { const int pi = lane + 64 * i; const float p = __builtin_amdgcn_exp2f(v[i] - mx); ls += p; if (pi < 387) sc[pi] = p; }
                        ls = wave_sum(ls);
                        if (lane == 0) sc[500] = 1.0f / ls;
                    }
                    __syncthreads();
                    {
                        const int part = tid >> 5, d4 = (tid & 31) * 4; f32x4 acc = (f32x4){0.f, 0.f, 0.f, 0.f};
#pragma unroll 5
                        for (int it = 0; it < 25; ++it) {
                            const int pi = part + 16 * it, pc = pi < 387 ? pi : 386;
                            const int gq = pc / 129, j = pc % 129, dl = gq == 0 ? 1 : (gq == 1 ? 4 : 16);
                            const GAS float* vp = (j == 0) ? out + O_CVS + ((size_t)b * WMAX + (WMAX - 1)) * D : cache_v + ((size_t)b * WMAX + (WMAX - dl * j)) * D;
                            const float p = pi < 387 ? sc[pc] : 0.f;
                            acc += *(const GAS f32x4*)(vp + h * HD + d4) * p;
                        }
                        red[part * 32 + (tid & 31)] = acc;
                    }
                    __syncthreads();
                    if (tid < 128) { const LAS float* rf = (const LAS float*)red; float o = 0.f;
#pragma unroll
                        for (int pt = 0; pt < 16; ++pt) o += rf[pt * 128 + tid];
                        o *= sc[500];
                        PBUF[(size_t)(MP + b) * D + h * HD + tid] = (bf16_t)(cvt_pk_bf16(o, 0.f) & 0xffffu); }
                }
            }
            GRID_BAR();
            {
                int t_ = threadIdx.x; asm volatile("" : "+v"(t_)); const int tid = t_, lane = tid & 63, wave = __builtin_amdgcn_readfirstlane(tid >> 6); (void)lane; (void)wave;
                GAS unsigned char* ws = ldp(lds, 21);
                const GAS bf16_t* OG = (const GAS bf16_t*)(ws + WS_OG); const GAS float* lse = (const GAS float*)(ws + WS_LSE); GAS bf16_t* PBUF = (GAS bf16_t*)(ws + WS_PB);
                const size_t gtid = (size_t)bx * 512 + tid, GT = (size_t)G * 512;
                constexpr size_t NIT = (size_t)MP * 128;
                size_t i = gtid;
                for (; i + 3 * GT < NIT; i += 4 * GT) {
                    float l[4][3]; u32x4 og[4][3];
#pragma unroll
                    for (int q = 0; q < 4; ++q) { const size_t it = i + q * GT, row = it >> 7; const int ch = (int)(it & 127), h = ch >> 4;
#pragma unroll
                        for (int g3 = 0; g3 < 3; ++g3) { l[q][g3] = lse[((size_t)g3 * MT + row) * 8 + h]; og[q][g3] = *(const GAS u32x4*)(OG + ((size_t)g3 * MT + row) * D + ch * 8); } }
#pragma unroll
                    for (int q = 0; q < 4; ++q) { const size_t it = i + q * GT, row = it >> 7; const int ch = (int)(it & 127);
                        const float m = fmaxf(l[q][0], fmaxf(l[q][1], l[q][2]));
                        float w0 = __builtin_amdgcn_exp2f(l[q][0] - m), w1 = __builtin_amdgcn_exp2f(l[q][1] - m), w2 = __builtin_amdgcn_exp2f(l[q][2] - m);
                        const float inv = 1.0f / (w0 + w1 + w2); w0 *= inv; w1 *= inv; w2 *= inv;
                        u32x4 o;
#pragma unroll
                        for (int e = 0; e < 4; ++e) {
                            const float lo = w0 * __uint_as_float(og[q][0][e] << 16) + w1 * __uint_as_float(og[q][1][e] << 16) + w2 * __uint_as_float(og[q][2][e] << 16);
                            const float hi = w0 * __uint_as_float(og[q][0][e] & 0xffff0000u) + w1 * __uint_as_float(og[q][1][e] & 0xffff0000u) + w2 * __uint_as_float(og[q][2][e] & 0xffff0000u);
                            o[e] = cvt_pk_bf16(lo, hi);
                        }
                        *(GAS u32x4*)(PBUF + row * D + ch * 8) = o; }
                }
                for (; i < NIT; i += GT) {
                    const size_t row = i >> 7; const int ch = (int)(i & 127), h = ch >> 4;
                    const float l0 = lse[((size_t)0 * MT + row) * 8 + h], l1 = lse[((size_t)1 * MT + row) * 8 + h], l2 = lse[((size_t)2 * MT + row) * 8 + h];
                    const float m = fmaxf(l0, fmaxf(l1, l2));
                    float w0 = __builtin_amdgcn_exp2f(l0 - m), w1 = __builtin_amdgcn_exp2f(l1 - m), w2 = __builtin_amdgcn_exp2f(l2 - m);
                    const float inv = 1.0f / (w0 + w1 + w2); w0 *= inv; w1 *= inv; w2 *= inv;
                    const u32x4 a = *(const GAS u32x4*)(OG + ((size_t)0 * MT + row) * D + ch * 8), bb = *(const GAS u32x4*)(OG + ((size_t)1 * MT + row) * D + ch * 8), c = *(const GAS u32x4*)(OG + ((size_t)2 * MT + row) * D + ch * 8);
                    u32x4 o;
#pragma unroll
                    for (int e = 0; e < 4; ++e) {
                        const float lo = w0 * __uint_as_float(a[e] << 16) + w1 * __uint_as_float(bb[e] << 16) + w2 * __uint_as_float(c[e] << 16);
                        const float hi = w0 * __uint_as_float(a[e] & 0xffff0000u) + w1 * __uint_as_float(bb[e] & 0xffff0000u) + w2 * __uint_as_float(c[e] & 0xffff0000u);
                        o[e] = cvt_pk_bf16(lo, hi);
                    }
                    *(GAS u32x4*)(PBUF + row * D + ch * 8) = o;
                }
            }
            GRID_BAR();
        }
        {
            const LAS unsigned* wv = (const LAS unsigned*)(lds + TAB_OFF + 256 + gi * 64);
            unsigned v[16];
#pragma unroll
            for (int j = 0; j < 16; ++j) v[j] = __builtin_amdgcn_readfirstlane(wv[j]);
#define U64(a, b) (((unsigned long long)(b) << 32) | (a))
            pg8::Gemm g{(const GAS bf16_t*)U64(v[0], v[1]), (const GAS bf16_t*)U64(v[2], v[3]), MP, (int)v[8], (int)v[9], (int)v[10], (int)v[11]};
            GAS unsigned char* ws = ldp(lds, 21);
            EpiAll E{(int)v[12], (GAS void*)U64(v[4], v[5]), (GAS void*)U64(v[6], v[7]), (GAS float*)(ws + WS_SSQ), (const GAS float*)(ws + WS_ROPE), (GAS float*)ldp(lds, 20), __uint_as_float(v[14]), lds};
#undef U64
            { const int item = G - 1 - bx; if (item < (g.N >> 6)) skinny_item(lds, g, E, item); }
            pg8::StaticOrder S; S.init(MP, g.N, G, bx);
            pg8::gemm_phase(lds, g, S, E);
            if (v[13]) GRID_BAR();
        }
    }
    {
        int t_ = threadIdx.x; asm volatile("" : "+v"(t_)); const int tid = t_, lane = tid & 63, wave = __builtin_amdgcn_readfirstlane(tid >> 6);
        GAS unsigned char* ws = ldp(lds, 21); GAS float* out = (GAS float*)ldp(lds, 20); const GAS float* final_norm = (const GAS float*)ldp(lds, 19);
        const GAS float* ssq = (const GAS float*)(ws + WS_SSQ); const GAS bf16_t* XB = (const GAS bf16_t*)(ws + WS_XB);
        const int gw = bx * 8 + wave, NGW = G * 8;
        const GAS f32x4* gn = (const GAS f32x4*)final_norm + lane;
        const f32x4 g0 = gn[0], g1 = gn[64], g2 = gn[128], g3 = gn[192];
#define UNPK(q_) ((f32x4){__uint_as_float((q_).x << 16), __uint_as_float((q_).x & 0xffff0000u), __uint_as_float((q_).y << 16), __uint_as_float((q_).y & 0xffff0000u)})
        int row = gw;
        for (; row + 3 * NGW < MV; row += 4 * NGW) {
            f32x4 s4[4]; u32x2 q[4][4];
#pragma unroll
            for (int b4 = 0; b4 < 4; ++b4) { const int rw = row + b4 * NGW; s4[b4] = *(const GAS f32x4*)(ssq + (size_t)rw * 16 + 4 * (lane & 3));
                const GAS u32x2* xr = (const GAS u32x2*)(XB + (size_t)rw * D) + lane; q[b4][0] = xr[0]; q[b4][1] = xr[64]; q[b4][2] = xr[128]; q[b4][3] = xr[192]; }
#pragma unroll
            for (int b4 = 0; b4 < 4; ++b4) { const int rw = row + b4 * NGW;
                float s = (s4[b4][0] + s4[b4][1]) + (s4[b4][2] + s4[b4][3]); s += __shfl_xor(s, 1); s += __shfl_xor(s, 2);
                const float r = rsqrtf(s * (1.0f / D) + RMS_EPS);
                GAS f32x4* yo = (GAS f32x4*)(out + (size_t)rw * D) + lane;
                __builtin_nontemporal_store(UNPK(q[b4][0]) * r * g0, yo); __builtin_nontemporal_store(UNPK(q[b4][1]) * r * g1, yo + 64);
                __builtin_nontemporal_store(UNPK(q[b4][2]) * r * g2, yo + 128); __builtin_nontemporal_store(UNPK(q[b4][3]) * r * g3, yo + 192); }
        }
        for (; row < MV; row += NGW) {
            const f32x4 s4 = *(const GAS f32x4*)(ssq + (size_t)row * 16 + 4 * (lane & 3));
            float s = (s4[0] + s4[1]) + (s4[2] + s4[3]); s += __shfl_xor(s, 1); s += __shfl_xor(s, 2);
            const float r = rsqrtf(s * (1.0f / D) + RMS_EPS);
            const GAS u32x2* xr = (const GAS u32x2*)(XB + (size_t)row * D) + lane;
            GAS f32x4* yo = (GAS f32x4*)(out + (size_t)row * D) + lane;
            const u32x2 q0 = xr[0], q1 = xr[64], q2 = xr[128], q3 = xr[192];
            __builtin_nontemporal_store(UNPK(q0) * r * g0, yo); __builtin_nontemporal_store(UNPK(q1) * r * g1, yo + 64);
            __builtin_nontemporal_store(UNPK(q2) * r * g2, yo + 128); __builtin_nontemporal_store(UNPK(q3) * r * g3, yo + 192);
#undef UNPK
        }
    }
}

extern "C" void kernel_launch(void* const* d_in, const int* in_sizes, int n_in, void* d_out, int out_size, void* d_ws, size_t ws_size, hipStream_t stream) {
    static int grid = 0;
    if (grid == 0) {
        if (n_in != 20 || ws_size < WS_END) { fprintf(stderr, "kernel_launch: unexpected n_in %d / ws %zu (need %zu)\n", n_in, ws_size, (size_t)WS_END); grid = -1; return; }
        int dev = 0, cus = 0, per_cu = 0;
        hipGetDevice(&dev); hipDeviceGetAttribute(&cus, hipDeviceAttributeMultiprocessorCount, dev);
        hipFuncSetAttribute((const void*)yoco_fwd, hipFuncAttributeMaxDynamicSharedMemorySize, LDS_BYTES);
        hipOccupancyMaxActiveBlocksPerMultiprocessor(&per_cu, (const void*)yoco_fwd, 512, LDS_BYTES);
        if (per_cu < 1) { fprintf(stderr, "kernel_launch: occupancy query says %d blocks/CU\n", per_cu); per_cu = 1; }
        (void)hipGetLastError();
        grid = cus * 1;
    }
    if (grid < 0) return;
    Params p{};
    for (int i = 0; i < 20; ++i) p.in[i] = (const float*)d_in[i];
    p.out = (float*)d_out; p.ws = (unsigned char*)d_ws;
    static const double invf[16] = {1.0, 0.44036660267178046, 0.19392274474868576, 0.08539710028576561, 0.03760603093086393, 0.016560440080994446, 0.007292664737217109, 0.003211445994752591,
                                    0.001414213562373095, 0.000622772421914596, 0.0002742481756762073, 0.00012076973741146504, 5.318295896944988e-05, 2.341999896140934e-05, 1.031338537721246e-05, 4.5416704806078695e-06};
    for (int i = 0; i < 16; ++i) p.invf[i] = invf[i];
    (void)hipMemsetAsync(d_ws, 0, 16384, stream);
    void* args[] = {&p};
    hipError_t e = hipLaunchCooperativeKernel((const void*)yoco_fwd, dim3(grid), dim3(512), args, LDS_BYTES, stream);
    if (e != hipSuccess) fprintf(stderr, "cooperative launch failed: %s (grid %d)\n", hipGetErrorString(e), grid);
}
```

```cpp
#include <hip/hip_runtime.h>
#include <hip/hip_cooperative_groups.h>
#include <cstdio>
#include <cstdint>
namespace cg = cooperative_groups;

#define LAS __attribute__((address_space(3)))
#if defined(__HIP_DEVICE_COMPILE__)
#define GAS __attribute__((address_space(1)))
#else
#define GAS
#endif
typedef unsigned short bf16_t;
typedef short bf16x8 __attribute__((ext_vector_type(8)));
typedef short s16x4 __attribute__((ext_vector_type(4)));
typedef float f32x4 __attribute__((ext_vector_type(4)));
typedef float f32x2 __attribute__((ext_vector_type(2)));
typedef unsigned u32x4 __attribute__((ext_vector_type(4)));
typedef unsigned u32x2 __attribute__((ext_vector_type(2)));

constexpr int D = 1024, FF = 2816, NB = 4, SEQ = 8192, MP = NB * SEQ  , NS = 32  ;
constexpr int MT = MP + 256;
constexpr int MV = MP + NS;
constexpr int NH = 8, HD = 128, WMAX = 2048, PB = 15;
constexpr int NQ = 3 * D;
constexpr float RMS_EPS = 1e-6f;
constexpr float QSCALE = 0.08838834764831845f * 1.4426950408889634f;

constexpr size_t O_YP = 0, O_YS = (size_t)MP * D, O_SPP = O_YS + (size_t)NS * D, O_SPS = O_SPP + (size_t)NB * PB * D,
                 O_CKP = O_SPS + (size_t)NS * PB * D, O_CVP = O_CKP + (size_t)NB * WMAX * D, O_CKS = O_CVP + (size_t)NB * WMAX * D,
                 O_CVS = O_CKS + (size_t)NS * WMAX * D;

constexpr size_t MiB = 1u << 20;
constexpr size_t WS_WIN = 1 * MiB;
constexpr size_t WIN_BYTES = (size_t)2 * FF * D * 2;
constexpr size_t WS_WOUT = WS_WIN + 4 * WIN_BYTES;
constexpr size_t WOUT_BYTES = (size_t)D * FF * 2;
constexpr size_t WS_WPG = WS_WOUT + 4 * WOUT_BYTES;
constexpr size_t WS_WPO = WS_WPG + (size_t)D * 256 * 2;
constexpr size_t WS_WKV = WS_WPO + (size_t)D * D * 2;
constexpr size_t WS_WQ = WS_WKV + (size_t)2 * D * D * 2;
constexpr size_t WS_WO = WS_WQ + (size_t)NQ * D * 2;
constexpr size_t WS_ROPE = WS_WO + (size_t)D * D * 2;
constexpr size_t WS_SSQ = WS_ROPE + (size_t)8200 * 32 * 4;
constexpr size_t WS_LSE = WS_SSQ + (size_t)MT * 16 * 4;
constexpr size_t WS_XF = (WS_LSE + (size_t)3 * MT * 8 * 4 + 4095) & ~(size_t)4095;
constexpr size_t WS_XB = WS_XF + (size_t)MT * D * 4;
constexpr size_t WS_ACT = WS_XB + (size_t)MT * D * 2;
constexpr size_t WS_PB = WS_ACT + (size_t)MT * FF * 2;
constexpr size_t WS_ZB = WS_PB + (size_t)MT * D * 2;
constexpr size_t WS_KB = WS_ZB + (size_t)MT * D * 2;
constexpr size_t WS_VB = WS_KB + (size_t)MT * D * 2;
constexpr size_t WS_QB = WS_VB + (size_t)MT * D * 2;
constexpr size_t WS_OG = WS_QB + (size_t)MT * NQ * 2;
constexpr size_t WS_END = WS_OG + (size_t)3 * MT * D * 2;

constexpr int LDS_BYTES = 147456;

struct Params {
    const float* in[20];
    float* out;
    unsigned char* ws;
    double invf[16];
};

__device__ __forceinline__ unsigned cvt_pk_bf16(float lo, float hi) { unsigned r; asm volatile("v_cvt_pk_bf16_f32 %0, %1, %2" : "=v"(r) : "v"(lo), "v"(hi)); return r; }
__device__ __forceinline__ float bf2f(unsigned short b) { return __uint_as_float((unsigned)b << 16); }
__device__ __forceinline__ float wave_sum(float v) {
#pragma unroll
    for (int o = 1; o < 64; o <<= 1) v += __shfl_xor(v, o);
    return v;
}
__device__ __forceinline__ float wave_max(float v) {
#pragma unroll
    for (int o = 1; o < 64; o <<= 1) v = fmaxf(v, __shfl_xor(v, o));
    return v;
}

namespace pg8 {
constexpr int BM = 256, BK = 64, HALF = 128, HTB = HALF * BK * 2, STAGE_BYTES = 8 * HTB, NXCD = 8, WGM = 8;
__host__ __device__ __forceinline__ int lds_byte(int r, int c) { const int st = (r >> 4) * 2 + (c >> 5), rr = r & 15, cc = c & 31, ob = rr * 64 + cc * 2; return st * 1024 + (ob ^ (((ob >> 9) & 1) << 5)); }
__host__ __device__ __forceinline__ void stage_rc(int b, int& R, int& C) { const int st = b / 1024, sb = b % 1024, swz = sb ^ (((sb >> 9) & 1) << 5); R = (st >> 1) * 16 + swz / 64; C = (st & 1) * 32 + (swz % 64) / 2; }
__host__ __device__ __forceinline__ int perm32(int rho) { const int n = rho >> 4, i = rho & 15; return 8 * (i >> 2) + 4 * n + (i & 3); }

struct Unit { int pm, pn, ui; };
struct Gemm { const GAS bf16_t* A; const GAS bf16_t* Bt; int M, N, K, lda, acol; };

struct StaticOrder {
    int nM, nN, nwg, G, c;
    __device__ void init(int M, int N, int G_, int c_) { nM = M / BM; nN = N / BM; nwg = nM * nN; G = G_; c = c_; }
    __device__ bool next(int i, Unit& u) const {
        const long L = (long)i * G + c; if (L >= nwg) return false;
        int wgid = (int)L; { const int q = nwg / NXCD, r = nwg % NXCD, xcd = wgid % NXCD, off = wgid / NXCD; wgid = (xcd < r ? xcd * (q + 1) : r * (q + 1) + (xcd - r) * q) + off; }
        const int nig = WGM * nN, gid = wgid / nig, fm = gid * WGM, gsz = (nM - fm) < WGM ? (nM - fm) : WGM;
        u.pm = fm + ((wgid % nig) % gsz); u.pn = (wgid % nig) / gsz; u.ui = i; return true;
    }
};

template <class Epi>
__device__ __forceinline__ void gemm_phase(LAS unsigned char* lds, const Gemm g, const StaticOrder& S, const Epi& E) {
    const bool PERMR = E.perm();
    const int tid = threadIdx.x, wid = __builtin_amdgcn_readfirstlane(tid >> 6), lane = tid & 63, wr = wid >> 2, wc = wid & 3, fr = lane & 15, fq = lane >> 4;
    const int K = g.K, nt = K / BK;
    unsigned voffA[2], voffB[2];
#pragma unroll
    for (int i = 0; i < 2; ++i) { int R, C; stage_rc(tid * 16 + i * 8192, R, C); const int Rb = PERMR ? ((R & ~31) + perm32(R & 31)) : R;
        voffA[i] = (unsigned)(R * g.lda + C) * 2u; voffB[i] = (unsigned)(Rb * K + C) * 2u; }
    const size_t kstep = (size_t)(BK * 2);
    const size_t hstepA = (size_t)HALF * g.lda * 2, hstepB = (size_t)HALF * K * 2;
    const unsigned ldsw = (unsigned)wid * 1024u;
    const int aoff = lds_byte(wr * 64 + fr, fq * 8), boff = lds_byte(wc * 32 + fr, fq * 8);
#define PG8_SA(b, h) (((b) * 2 + (h)) * HTB)
#define PG8_SB(b, h) ((4 + (b) * 2 + (h)) * HTB)
#define PG8_STAGE(bufoff, gbase, voff) do { _Pragma("unroll") for (int _i = 0; _i < 2; ++_i) \
        __builtin_amdgcn_global_load_lds((const unsigned*)((const char*)(gbase) + (voff)[_i]), (LAS unsigned*)(lds + (bufoff) + ldsw + _i * 8192), 16, 0, 0); } while (0)
#define PG8_LDA(dst, b, h) do { _Pragma("unroll") for (int m = 0; m < 4; ++m) _Pragma("unroll") for (int k = 0; k < 2; ++k) dst[m][k] = *(const LAS bf16x8*)(lds + PG8_SA(b, h) + aoff + m * 2048 + k * 1024); } while (0)
#define PG8_LDB(dst, b, h) do { _Pragma("unroll") for (int n = 0; n < 2; ++n) _Pragma("unroll") for (int k = 0; k < 2; ++k) dst[n][k] = *(const LAS bf16x8*)(lds + PG8_SB(b, h) + boff + n * 2048 + k * 1024); } while (0)
#define PG8_MMA(ai, bj, At, Bt) do { __builtin_amdgcn_s_setprio(1); _Pragma("unroll") for (int m = 0; m < 4; ++m) _Pragma("unroll") for (int n = 0; n < 2; ++n) _Pragma("unroll") for (int k = 0; k < 2; ++k) \
        acc[ai][bj][m][n] = __builtin_amdgcn_mfma_f32_16x16x32_bf16(Bt[n][k], At[m][k], acc[ai][bj][m][n], 0, 0, 0); __builtin_amdgcn_s_setprio(0); } while (0)
#define PG8_WAIT_V(n) asm volatile("s_waitcnt vmcnt(" #n ")" ::: "memory")
#define PG8_WAIT_L(n) asm volatile("s_waitcnt lgkmcnt(" #n ")" ::: "memory")
#define PG8_BAR __builtin_amdgcn_s_barrier()
#define PG8_SCHED __builtin_amdgcn_sched_barrier(0)
    Unit cur, nxt; int ui = 0;
    if (!S.next(0, cur)) return;
    f32x4 acc[2][2][4][2];
#pragma unroll
    for (int a = 0; a < 2; ++a)
#pragma unroll
        for (int b = 0; b < 2; ++b)
#pragma unroll
            for (int m = 0; m < 4; ++m)
#pragma unroll
                for (int n = 0; n < 2; ++n) acc[a][b][m][n] = (f32x4){0.f, 0.f, 0.f, 0.f};
    bf16x8 At[4][2], B0[2][2], B1[2][2];
    const char* cA = (const char*)g.A + (size_t)cur.pm * 2 * hstepA + (size_t)cur.pn * g.acol * 2;
    const char* cB = (const char*)g.Bt + (size_t)cur.pn * 2 * hstepB;
    PG8_STAGE(PG8_SB(0, 0), cB, voffB); PG8_STAGE(PG8_SB(0, 1), cB + hstepB, voffB); PG8_STAGE(PG8_SA(0, 0), cA, voffA); PG8_STAGE(PG8_SA(0, 1), cA + hstepA, voffA);
    if (wr == 1) PG8_BAR;
    PG8_WAIT_V(2); PG8_BAR;
    PG8_STAGE(PG8_SB(1, 0), cB + kstep, voffB); PG8_STAGE(PG8_SA(1, 0), cA + kstep, voffA); PG8_STAGE(PG8_SB(1, 1), cB + hstepB + kstep, voffB);
    PG8_WAIT_V(6); PG8_BAR;
    for (;;) {
        const bool has_next = S.next(ui + 1, nxt);
        const char* nA = has_next ? (const char*)g.A + (size_t)nxt.pm * 2 * hstepA + (size_t)nxt.pn * g.acol * 2 : cA;
        const char* nB = has_next ? (const char*)g.Bt + (size_t)nxt.pn * 2 * hstepB : cB;
        for (int t = 0; t < nt; t += 2) {
            const bool last = (t == nt - 2);
            const char* a1 = cA + (size_t)(t + 1) * kstep;
            const char* a2 = last ? nA : cA + (size_t)(t + 2) * kstep; const char* b2 = last ? nB : cB + (size_t)(t + 2) * kstep;
            const char* a3 = a2 + kstep; const char* b3 = b2 + kstep;
            PG8_LDB(B0, 0, 0); PG8_LDB(B1, 0, 1); PG8_SCHED; PG8_LDA(At, 0, 0); PG8_STAGE(PG8_SA(1, 1), a1 + hstepA, voffA);
            PG8_WAIT_V(8); PG8_WAIT_L(0); PG8_BAR; PG8_MMA(0, 0, At, B0); PG8_MMA(0, 1, At, B1); PG8_BAR; PG8_SCHED;
            PG8_LDA(At, 0, 1); PG8_STAGE(PG8_SB(0, 0), b2, voffB); PG8_STAGE(PG8_SB(0, 1), b2 + hstepB, voffB); PG8_STAGE(PG8_SA(0, 0), a2, voffA);
            PG8_WAIT_V(8); PG8_WAIT_L(0); PG8_BAR; PG8_MMA(1, 0, At, B0); PG8_MMA(1, 1, At, B1); PG8_BAR; PG8_SCHED;
            PG8_LDB(B0, 1, 0); PG8_LDB(B1, 1, 1); PG8_SCHED; PG8_LDA(At, 1, 0); PG8_STAGE(PG8_SA(0, 1), a2 + hstepA, voffA);
            PG8_WAIT_V(8); PG8_WAIT_L(0); PG8_BAR; PG8_MMA(0, 0, At, B0); PG8_MMA(0, 1, At, B1); PG8_BAR; PG8_SCHED;
            PG8_LDA(At, 1, 1); PG8_STAGE(PG8_SB(1, 0), b3, voffB); PG8_STAGE(PG8_SB(1, 1), b3 + hstepB, voffB); PG8_STAGE(PG8_SA(1, 0), a3, voffA);
            PG8_WAIT_V(8); PG8_WAIT_L(0); PG8_BAR; PG8_MMA(1, 0, At, B0); PG8_MMA(1, 1, At, B1); PG8_BAR; PG8_SCHED;
        }
        if (wr == 0) PG8_BAR;
        E(acc, cur, wr, wc, fr, fq);
        if (!has_next) break;
#pragma unroll
        for (int a = 0; a < 2; ++a)
#pragma unroll
            for (int b = 0; b < 2; ++b)
#pragma unroll
                for (int m = 0; m < 4; ++m)
#pragma unroll
                    for (int n = 0; n < 2; ++n) acc[a][b][m][n] = (f32x4){0.f, 0.f, 0.f, 0.f};
        cur = nxt; cA = nA; cB = nB; ++ui;
        if (wr == 1) PG8_BAR;
    }
    PG8_WAIT_V(0);
    PG8_BAR;
#undef PG8_SA
#undef PG8_SB
#undef PG8_STAGE
#undef PG8_LDA
#undef PG8_LDB
#undef PG8_MMA
#undef PG8_WAIT_V
#undef PG8_WAIT_L
#undef PG8_BAR
#undef PG8_SCHED
}
}
using pg8::Unit;

__device__ __forceinline__ float row_rs(const GAS float* ssq, int row, int fq) {
    const f32x4 v = *(const GAS f32x4*)(ssq + (size_t)row * 16 + fq * 4);
    float s = (v[0] + v[1]) + (v[2] + v[3]);
    s += __shfl_xor(s, 16); s += __shfl_xor(s, 32);
    return rsqrtf(s * (1.0f / D) + RMS_EPS);
}
__device__ __forceinline__ float silu_mul(float g, float u) { const float e = __builtin_amdgcn_exp2f(-g * 1.4426950408889634f); return g * __builtin_amdgcn_rcpf(1.0f + e) * u; }

constexpr int TAB_OFF_C = 131072;
struct EpiAll {
    int kind;
    GAS void* p0; GAS void* p1; GAS float* ssq; const GAS float* rope; GAS float* out; float alpha;
    LAS unsigned char* ldsb;
    __device__ __forceinline__ bool perm() const { return kind < 3 || kind == 5; }
    template <int NAI, int NM>
    __device__ __forceinline__ void swiglu(const f32x4 (&acc)[2][2][4][2], const Unit& u, int wr, int wc, int fr, int fq) const {
        GAS bf16_t* O = (GAS bf16_t*)p0;
        const int row0 = u.pm * 256 + wr * 64 + fr, col0 = u.pn * 128 + wc * 32 + 8 * fq;
        f32x4 cpv[6]; GAS f32x4* cpd[6];
        const bool cp_on = (NAI == 2) && ((128u * 22u) % gridDim.x == 0u);
        if (NAI == 2 && cp_on) {
            constexpr unsigned per_b = (unsigned)(WMAX - 1) * D / 4, full_b = (unsigned)WMAX * D / 4, tot = 2u * NS * per_b;
            const LAS unsigned* t = (const LAS unsigned*)(ldsb + TAB_OFF_C);
            const unsigned long long pk = ((unsigned long long)(unsigned)__builtin_amdgcn_readfirstlane(t[7]) << 32) | (unsigned long long)(unsigned)__builtin_amdgcn_readfirstlane(t[6]);
            const unsigned long long pv = ((unsigned long long)(unsigned)__builtin_amdgcn_readfirstlane(t[9]) << 32) | (unsigned long long)(unsigned)__builtin_amdgcn_readfirstlane(t[8]);
            const GAS f32x4* sk = (const GAS f32x4*)pk; const GAS f32x4* sv = (const GAS f32x4*)pv;
            GAS f32x4* dk = (GAS f32x4*)(out + O_CKS); GAS f32x4* dv = (GAS f32x4*)(out + O_CVS);
            const unsigned Gn = gridDim.x, upw = (128u * 22u + Gn - 1u) / Gn;
            const unsigned chunk = ((unsigned)alpha * upw + (unsigned)u.ui) * Gn + blockIdx.x;
#pragma unroll
            for (int k = 0; k < 6; ++k) { unsigned j = chunk * 3072u + threadIdx.x + 512u * (unsigned)k; const bool ok = j < tot; j = ok ? j : 0u;
                const unsigned ck = j / per_b, r = j - ck * per_b, b = ck >> 1;
                cpv[k] = __builtin_nontemporal_load(((ck & 1) ? sv : sk) + (size_t)b * full_b + (D / 4) + r);
                cpd[k] = ok ? ((ck & 1) ? dv : dk) + (size_t)b * full_b + r : (GAS f32x4*)nullptr; }
        }
#pragma unroll
        for (int ai = 0; ai < NAI; ++ai)
#pragma unroll
            for (int m = 0; m < NM; ++m) {
                const int row = row0 + ai * 128 + m * 16; const float r = row_rs(ssq, row, fq);
                const float r2 = r * r, cneg = r * -1.4426950408889634f;
                float o[8];
#pragma unroll
                for (int n = 0; n < 2; ++n)
#pragma unroll
                    for (int e = 0; e < 4; ++e) { const float g = acc[ai][0][m][n][e], uu = acc[ai][1][m][n][e];
                        o[n * 4 + e] = (g * uu) * r2 * __builtin_amdgcn_rcpf(1.0f + __builtin_amdgcn_exp2f(g * cneg)); }
                u32x4 w; w.x = cvt_pk_bf16(o[0], o[1]); w.y = cvt_pk_bf16(o[2], o[3]); w.z = cvt_pk_bf16(o[4], o[5]); w.w = cvt_pk_bf16(o[6], o[7]);
                *(GAS u32x4*)(O + (size_t)row * FF + col0) = w;
            }
        if (NAI == 2 && cp_on) {
#pragma unroll
            for (int k = 0; k < 6; ++k) if (cpd[k]) __builtin_nontemporal_store(cpv[k], cpd[k]);
        }
    }
    template <bool FINAL, int NAI, int NM>
    __device__ __forceinline__ void res(const f32x4 (&acc)[2][2][4][2], const Unit& u, int wr, int wc, int fr, int fq) const {
        GAS float* X = (GAS float*)p0; GAS bf16_t* XB = (GAS bf16_t*)p1;
        const int row0 = u.pm * 256 + wr * 64 + fr, col0 = u.pn * 256 + wc * 32 + 8 * fq;
#pragma unroll
        for (int ai = 0; ai < NAI; ++ai)
#pragma unroll
            for (int m = 0; m < NM; ++m) {
                const int row = row0 + ai * 128 + m * 16; float ss = 0.f;
#pragma unroll
                for (int bj = 0; bj < 2; ++bj) {
                    GAS bf16_t* px = XB + (size_t)row * D + col0 + bj * 128;
                    const u32x4 ob = *(const GAS u32x4*)px;
                    const f32x4 b0 = (f32x4){__uint_as_float(ob.x << 16), __uint_as_float(ob.x & 0xffff0000u), __uint_as_float(ob.y << 16), __uint_as_float(ob.y & 0xffff0000u)};
                    const f32x4 b1 = (f32x4){__uint_as_float(ob.z << 16), __uint_as_float(ob.z & 0xffff0000u), __uint_as_float(ob.w << 16), __uint_as_float(ob.w & 0xffff0000u)};
                    const f32x4 v0 = b0 + acc[ai][bj][m][0] * alpha, v1 = b1 + acc[ai][bj][m][1] * alpha;
                    ss += (v0[0] * v0[0] + v0[1] * v0[1]) + (v0[2] * v0[2] + v0[3] * v0[3]) + (v1[0] * v1[0] + v1[1] * v1[1]) + (v1[2] * v1[2] + v1[3] * v1[3]);
                    if (FINAL) { GAS float* pf = X + (size_t)row * D + col0 + bj * 128; *(GAS f32x4*)pf = v0; *(GAS f32x4*)(pf + 4) = v1; }
                    else { u32x4 w; w.x = cvt_pk_bf16(v0[0], v0[1]); w.y = cvt_pk_bf16(v0[2], v0[3]); w.z = cvt_pk_bf16(v1[0], v1[1]); w.w = cvt_pk_bf16(v1[2], v1[3]); *(GAS u32x4*)px = w; }
                }
                ss += __shfl_xor(ss, 16); ss += __shfl_xor(ss, 32);
                if (fq == 0) ssq[(size_t)row * 16 + u.pn * 4 + wc] = ss;
            }
    }
    template <int NAI, int NM>
    __device__ __forceinline__ void store(const f32x4 (&acc)[2][2][4][2], const Unit& u, int wr, int wc, int fr, int fq) const {
        GAS bf16_t* O = (GAS bf16_t*)p0;
        const int row0 = u.pm * 256 + wr * 64 + fr, col0 = u.pn * 256 + wc * 32 + 8 * fq;
#pragma unroll
        for (int ai = 0; ai < NAI; ++ai)
#pragma unroll
            for (int m = 0; m < NM; ++m) {
                const int row = row0 + ai * 128 + m * 16;
#pragma unroll
                for (int bj = 0; bj < 2; ++bj) {
                    const f32x4 v0 = acc[ai][bj][m][0], v1 = acc[ai][bj][m][1];
                    u32x4 w; w.x = cvt_pk_bf16(v0[0], v0[1]); w.y = cvt_pk_bf16(v0[2], v0[3]); w.z = cvt_pk_bf16(v1[0], v1[1]); w.w = cvt_pk_bf16(v1[2], v1[3]);
                    *(GAS u32x4*)(O + (size_t)row * D + col0 + bj * 128) = w;
                }
            }
    }
    template <bool ISQ, int NAI, int NM>
    __device__ __forceinline__ void kvq(const f32x4 (&acc)[2][2][4][2], const Unit& u, int wr, int wc, int fr, int fq) const {
        const int row0 = u.pm * 256 + wr * 64 + fr;
        const bool isK = ISQ || u.pn < 4;
        const int colb = (ISQ ? u.pn : (u.pn & 3)) * 256 + wc * 32 + 4 * fq;
        GAS bf16_t* dstb = (GAS bf16_t*)((ISQ || isK) ? p0 : p1);
        const int ldo = ISQ ? NQ : D;
        const bool dorope = isK && wc == 0;
#pragma unroll
        for (int ai = 0; ai < NAI; ++ai)
#pragma unroll
            for (int m = 0; m < NM; ++m) {
                const int row = row0 + ai * 128 + m * 16; const float r = row_rs(ssq, row, fq) * (ISQ ? QSCALE : 1.0f);
                const bool prompt = row < MP;
                const int t = row & (SEQ - 1), b = row >> 13, sb = row - MP;
                const int pidx = prompt ? t : SEQ;
                GAS float* fdst = nullptr;
                if (!ISQ) {
                    if (prompt) { if (t >= SEQ - WMAX) fdst = out + (isK ? O_CKP : O_CVP) + ((size_t)b * WMAX + (t - (SEQ - WMAX))) * D; }
                    else if (sb < NS) fdst = out + (isK ? O_CKS : O_CVS) + ((size_t)sb * WMAX + (WMAX - 1)) * D;
                }
                f32x4 cs = (f32x4){1.f, 1.f, 1.f, 1.f}, sn = (f32x4){0.f, 0.f, 0.f, 0.f};
                if (dorope) { cs = *(const GAS f32x4*)(rope + (size_t)pidx * 32 + 4 * fq); sn = *(const GAS f32x4*)(rope + (size_t)pidx * 32 + 16 + 4 * fq); }
#pragma unroll
                for (int bj = 0; bj < 2; ++bj) {
                    f32x4 v0 = acc[ai][bj][m][0] * r, v1 = acc[ai][bj][m][1] * r;
                    if (dorope) { const f32x4 r1 = v0 * cs - v1 * sn, r2 = v1 * cs + v0 * sn; v0 = r1; v1 = r2; }
                    const int c = colb + bj * 128;
                    u32x2 w0, w1; w0.x = cvt_pk_bf16(v0[0], v0[1]); w0.y = cvt_pk_bf16(v0[2], v0[3]); w1.x = cvt_pk_bf16(v1[0], v1[1]); w1.y = cvt_pk_bf16(v1[2], v1[3]);
                    *(GAS u32x2*)(dstb + (size_t)row * ldo + c) = w0; *(GAS u32x2*)(dstb + (size_t)row * ldo + c + 16) = w1;
                    if (!ISQ) { if (fdst) { *(GAS f32x4*)(fdst + c) = v0; *(GAS f32x4*)(fdst + c + 16) = v1; } }
                }
            }
    }
    template <int NAI, int NM>
    __device__ __forceinline__ void run(const f32x4 (&acc)[2][2][4][2], const Unit& u, int wr, int wc, int fr, int fq) const {
        if (kind == 0) swiglu<NAI, NM>(acc, u, wr, wc, fr, fq);
        else if (kind == 1) res<false, NAI, NM>(acc, u, wr, wc, fr, fq);
        else if (kind == 5) res<true, NAI, NM>(acc, u, wr, wc, fr, fq);
        else if (kind == 2) store<NAI, NM>(acc, u, wr, wc, fr, fq);
        else if (kind == 3) kvq<false, NAI, NM>(acc, u, wr, wc, fr, fq);
        else kvq<true, NAI, NM>(acc, u, wr, wc, fr, fq);
    }
    __device__ __forceinline__ void operator()(const f32x4 (&acc)[2][2][4][2], const Unit& u, int wr, int wc, int fr, int fq) const { run<2, 4>(acc, u, wr, wc, fr, fq); }
};

__device__ __forceinline__ void skinny_item(LAS unsigned char* lds, const pg8::Gemm g, const EpiAll& E, int item) {
    int t_ = threadIdx.x; asm volatile("" : "+v"(t_));
    const int tid = t_, lane = tid & 63, wave = __builtin_amdgcn_readfirstlane(tid >> 6), fr = lane & 15, fq = lane >> 4;
    const int pn = item >> 2, wc = item & 3, K = g.K, ksp = K >> 3, steps = ksp >> 5;
    const bool perm = E.perm();
    const GAS bf16_t* ap[2]; const GAS bf16_t* bp[2][2];
#pragma unroll
    for (int m = 0; m < 2; ++m) ap[m] = g.A + (size_t)(MP + 16 * m + fr) * g.lda + (size_t)pn * g.acol + wave * ksp + 8 * fq;
#pragma unroll
    for (int bj = 0; bj < 2; ++bj)
#pragma unroll
        for (int n = 0; n < 2; ++n) { const int rloc = perm ? (8 * (fr >> 2) + 4 * n + (fr & 3)) : (16 * n + fr);
            bp[bj][n] = g.Bt + (size_t)(256 * pn + 128 * bj + 32 * wc + rloc) * K + wave * ksp + 8 * fq; }
    f32x4 acc[2][2][4][2];
#pragma unroll
    for (int bj = 0; bj < 2; ++bj)
#pragma unroll
        for (int m = 0; m < 2; ++m)
#pragma unroll
            for (int n = 0; n < 2; ++n) acc[0][bj][m][n] = (f32x4){0.f, 0.f, 0.f, 0.f};
#pragma unroll 4
    for (int s = 0; s < steps; ++s) {
        bf16x8 a[2], b[2][2];
#pragma unroll
        for (int m = 0; m < 2; ++m) a[m] = *(const GAS bf16x8*)(ap[m] + 32 * s);
#pragma unroll
        for (int bj = 0; bj < 2; ++bj)
#pragma unroll
            for (int n = 0; n < 2; ++n) b[bj][n] = *(const GAS bf16x8*)(bp[bj][n] + 32 * s);
#pragma unroll
        for (int bj = 0; bj < 2; ++bj)
#pragma unroll
            for (int m = 0; m < 2; ++m)
#pragma unroll
                for (int n = 0; n < 2; ++n) acc[0][bj][m][n] = __builtin_amdgcn_mfma_f32_16x16x32_bf16(b[bj][n], a[m], acc[0][bj][m][n], 0, 0, 0);
    }
    LAS f32x4* red = (LAS f32x4*)lds;
#pragma unroll
    for (int bj = 0; bj < 2; ++bj)
#pragma unroll
        for (int m = 0; m < 2; ++m)
#pragma unroll
            for (int n = 0; n < 2; ++n) red[(wave * 8 + (bj * 4 + m * 2 + n)) * 64 + lane] = acc[0][bj][m][n];
    __syncthreads();
    if (wave == 0) {
#pragma unroll
        for (int bj = 0; bj < 2; ++bj)
#pragma unroll
            for (int m = 0; m < 2; ++m)
#pragma unroll
                for (int n = 0; n < 2; ++n) { f32x4 s = red[(bj * 4 + m * 2 + n) * 64 + lane];
#pragma unroll
                    for (int w = 1; w < 8; ++w) s += red[(w * 8 + (bj * 4 + m * 2 + n)) * 64 + lane];
                    acc[0][bj][m][n] = s; }
        Unit u; u.pm = MP / 256; u.pn = pn; u.ui = 0;
        E.run<1, 2>(acc, u, 0, wc, fr, fq);
    }
    __syncthreads();
}
__device__ __forceinline__ void transpose_item(const float* W, int K, int N, bf16_t* WT, int dst_row0, int k0, int n0, LAS float* scr, int lane, const float* kgain, const float* ngain) {
    { f32x4 v[8];
#pragma unroll
      for (int i = 0; i < 8; ++i) { const int kk = 8 * i + (lane >> 3); v[i] = *(const GAS f32x4*)(W + (size_t)(k0 + kk) * N + n0 + 4 * (lane & 7)); }
#pragma unroll
      for (int i = 0; i < 8; ++i) { const int kk = 8 * i + (lane >> 3); const float kg = kgain ? kgain[k0 + kk] : 1.0f; LAS float* d = scr + kk * 33 + 4 * (lane & 7);
          d[0] = v[i][0] * kg; d[1] = v[i][1] * kg; d[2] = v[i][2] * kg; d[3] = v[i][3] * kg; } }
    asm volatile("s_waitcnt lgkmcnt(0)" ::: "memory");
    const int c = lane & 7;
#pragma unroll
    for (int j = 0; j < 4; ++j) { const int n = (lane >> 3) + 8 * j; const LAS float* s = scr + (8 * c) * 33 + n; const float ng = ngain ? ngain[n0 + n] : 1.0f;
        u32x4 o; o.x = cvt_pk_bf16(s[0 * 33] * ng, s[1 * 33] * ng); o.y = cvt_pk_bf16(s[2 * 33] * ng, s[3 * 33] * ng); o.z = cvt_pk_bf16(s[4 * 33] * ng, s[5 * 33] * ng); o.w = cvt_pk_bf16(s[6 * 33] * ng, s[7 * 33] * ng);
        *(GAS u32x4*)(WT + (size_t)(dst_row0 + n) * K + k0 + 8 * c) = o; }
    asm volatile("s_waitcnt lgkmcnt(0)" ::: "memory");
}
__device__ __forceinline__ void transpose_matrix(const float* W, int K, int N, bf16_t* WT, int mode, const float* kgain, const float* ngain, LAS float* scr, int gw, int NGW, int lane) {
    const int nblk = N / 32, items = (K / 64) * nblk;
    for (int it = gw; it < items; it += NGW) {
        const int kb = it / nblk, nb = it % nblk, k0 = 64 * kb, n0 = 32 * nb;
        int dr = n0;
        if (mode == 1) { if (n0 < FF) dr = 256 * (n0 / 128) + (n0 % 128); else { const int f = n0 - FF; dr = 256 * (f / 128) + 128 + (f % 128); } }
        transpose_item(W, K, N, WT, dr, k0, n0, scr, lane, kgain, ngain);
    }
}
__device__ __forceinline__ void sincos_d(double x, double& s, double& c) {
    const double kq = rint(x * 0.63661977236758134308);
    double r = fma(-kq, 1.57079632679489655800e+00, x); r = fma(-kq, 6.12323399573676603587e-17, r);
    const double r2 = r * r;
    const double sp = r * (1.0 + r2 * (-1.0 / 6 + r2 * (1.0 / 120 + r2 * (-1.0 / 5040 + r2 * (1.0 / 362880 + r2 * (-1.0 / 39916800 + r2 * (1.0 / 6227020800.0 + r2 * (-1.0 / 1307674368000.0))))))));
    const double cp = 1.0 + r2 * (-0.5 + r2 * (1.0 / 24 + r2 * (-1.0 / 720 + r2 * (1.0 / 40320 + r2 * (-1.0 / 3628800 + r2 * (1.0 / 479001600.0 + r2 * (-1.0 / 87178291200.0 + r2 * (1.0 / 20922789888000.0))))))));
    const int q = (int)((long long)kq & 3);
    s = (q == 0) ? sp : (q == 1) ? cp : (q == 2) ? -sp : -cp;
    c = (q == 0) ? cp : (q == 1) ? -sp : (q == 2) ? -cp : sp;
}

__device__ __forceinline__ int kv_off(int row, int ch) { return 256 * row + 16 * (ch ^ (((row & 3) << 2) | ((row >> 2) & 3))); }

#define XB_TMO      128
#define XB_XCNT(j)  (256  + 64 * (j))
#define XB_XSUB(j)  (1280 + 64 * (j))
#define XB_XGEN(j)  (2304 + 64 * (j))
#define XB_TOP      3328
#define XB_TOPGEN   3392
#define XCD_BAR_WORDS 3456
#define XB_SPIN_CAP (1u << 18)

__device__ __forceinline__ unsigned xb_ld(unsigned* p)              { return __hip_atomic_load(p, __ATOMIC_RELAXED, __HIP_MEMORY_SCOPE_AGENT); }
__device__ __forceinline__ unsigned xb_add(unsigned* p, unsigned v) { return __hip_atomic_fetch_add(p, v, __ATOMIC_RELAXED, __HIP_MEMORY_SCOPE_AGENT); }
__device__ __forceinline__ unsigned xb_xcc_id() { return (unsigned)__builtin_amdgcn_s_getreg((3 << 11) | 20) & 0xFu; }
#define XB_SPIN(cond, bar) do { unsigned _sp = 0; while (cond) { __builtin_amdgcn_s_sleep(1); \
    if ((++_sp & 255u) == 0u) { if (xb_ld(&(bar)[XB_TMO])) break; if (_sp > XB_SPIN_CAP) { atomicAdd(&(bar)[XB_TMO], 1u); break; } } } } while (0)

struct XcdBarrier {
    unsigned* bar; unsigned x;
    volatile LAS unsigned* st;
};

__device__ __forceinline__ XcdBarrier xcd_barrier_post(unsigned* bar, volatile LAS unsigned* st) {
    XcdBarrier b; b.bar = bar; b.x = xb_xcc_id(); b.st = st;
    if (threadIdx.x == 0) (void)xb_add(&bar[XB_XCNT(b.x)], 1u);
    return b;
}
__device__ __forceinline__ void xcd_barrier_complete(unsigned* bar, unsigned x, unsigned& nloc, unsigned& nx) {
    const unsigned G = gridDim.x * gridDim.y * gridDim.z;
    unsigned sum, cnt, mine, sp = 0u;
    for (;;) {
        sum = 0u; cnt = 0u; mine = 0u;
#pragma unroll
        for (unsigned j = 0; j < 16; ++j) { const unsigned c = xb_ld(&bar[XB_XCNT(j)]); sum += c; cnt += (c > 0u) ? 1u : 0u; mine = (j == x) ? c : mine; }
        if (sum == G) break;
        __builtin_amdgcn_s_sleep(1);
        if ((++sp & 255u) == 0u) { if (xb_ld(&bar[XB_TMO])) break; if (sp > XB_SPIN_CAP) { atomicAdd(&bar[XB_TMO], 1u); break; } }
    }
    nloc = mine > 0u ? mine : 1u; nx = cnt > 0u ? cnt : 1u;
}

__device__ __forceinline__ void xcd_barrier(const XcdBarrier& b) {
    asm volatile("s_waitcnt vmcnt(0)" ::: "memory");
    __syncthreads();
    if (threadIdx.x == 0) {
        unsigned* bar = b.bar;
        __builtin_amdgcn_s_waitcnt(0);
        unsigned nloc = b.st[0], nx = b.st[1];
        if (nloc == 0u) { xcd_barrier_complete(bar, b.x, nloc, nx); b.st[0] = nloc; b.st[1] = nx; }
        const unsigned old = xb_add(&bar[XB_XSUB(b.x)], 1u);
        const unsigned gen = old / nloc;
        if (old + 1u == (gen + 1u) * nloc) {
            __builtin_amdgcn_fence(__ATOMIC_RELEASE, "agent");
            asm volatile("s_waitcnt vmcnt(0)" ::: "memory");
            const unsigned og = xb_add(&bar[XB_TOP], 1u);
            const unsigned tg = og / nx;
            if (og + 1u == (tg + 1u) * nx) xb_add(&bar[XB_TOPGEN], 1u);
            else XB_SPIN(xb_ld(&bar[XB_TOPGEN]) == tg, bar);
            __builtin_amdgcn_fence(__ATOMIC_ACQUIRE, "agent");
            xb_add(&bar[XB_XGEN(b.x)], 1u);
            asm volatile("s_waitcnt vmcnt(0)" ::: "memory");
        } else {
            XB_SPIN(xb_ld(&bar[XB_XGEN(b.x)]) == gen, bar);
            __builtin_amdgcn_fence(__ATOMIC_ACQUIRE, "agent");
            asm volatile("s_waitcnt vmcnt(0)" ::: "memory");
        }
    }
    __syncthreads();
}

constexpr int TAB_OFF = 131072;
struct GD { unsigned long long A, Bt, p0, p1; int N, K, lda, acol, kind, sync; float alpha; int pad; };
constexpr int NGEMM = 13;
__device__ __forceinline__ GAS unsigned char* ldp(LAS unsigned char* lds, int i) {
    const LAS unsigned* t = (const LAS unsigned*)(lds + TAB_OFF) + 2 * i;
    const unsigned lo = __builtin_amdgcn_readfirstlane(t[0]), hi = __builtin_amdgcn_readfirstlane(t[1]);
    return (GAS unsigned char*)(((unsigned long long)hi << 32) | lo);
}

#define XBAR_ST_OFF (TAB_OFF + 2048)
#define GRID_BAR() do { XcdBarrier b_; b_.bar = (unsigned*)ldp(lds, 21); b_.x = xb_xcc_id(); b_.st = (volatile LAS unsigned*)(lds + XBAR_ST_OFF); xcd_barrier(b_); } while (0)
__global__ void __launch_bounds__(512, 2) yoco_fwd(Params P) {
    extern __shared__ __attribute__((aligned(16))) unsigned char lds_raw[];
    LAS unsigned char* lds = (LAS unsigned char*)lds_raw;
    cg::grid_group grid = cg::this_grid();
    const int tid = threadIdx.x, lane = tid & 63, wave = __builtin_amdgcn_readfirstlane(tid >> 6);
    const int G = gridDim.x, bx = blockIdx.x;
    const size_t WIN_E = (size_t)2 * FF * D, WOUT_E = (size_t)D * FF;

    if (tid == 0) { ((volatile LAS unsigned*)(lds + XBAR_ST_OFF))[0] = 0u; ((volatile LAS unsigned*)(lds + XBAR_ST_OFF))[1] = 0u; }
    (void)xcd_barrier_post((unsigned*)P.ws, (volatile LAS unsigned*)(lds + XBAR_ST_OFF));
    if (tid == 0) {
        LAS unsigned long long* pt = (LAS unsigned long long*)(lds + TAB_OFF);
#define PT(i) pt[i] = (unsigned long long)P.in[i]
        PT(0); PT(1); PT(2); PT(3); PT(4); PT(5); PT(6); PT(7); PT(8); PT(9); PT(10); PT(11); PT(12); PT(13); PT(14); PT(15); PT(16); PT(17); PT(18); PT(19);
#undef PT
        pt[20] = (unsigned long long)P.out; pt[21] = (unsigned long long)P.ws;
        const unsigned long long w = (unsigned long long)P.ws;
        LAS GD* gd = (LAS GD*)(lds + TAB_OFF + 256);
        const unsigned long long XBp = w + WS_XB, ACTp = w + WS_ACT, XFp = w + WS_XF, PBp = w + WS_PB, ZBp = w + WS_ZB;
#define SETG(i, A_, B_, P0_, P1_, N_, K_, LDA_, AC_, KIND_, SYNC_, AL_) do { LAS unsigned long long* q_ = (LAS unsigned long long*)(gd + (i)); q_[0] = (A_); q_[1] = (B_); q_[2] = (P0_); q_[3] = (P1_); LAS int* r_ = (LAS int*)(q_ + 4); r_[0] = (N_); r_[1] = (K_); r_[2] = (LDA_); r_[3] = (AC_); r_[4] = (KIND_); r_[5] = (SYNC_); ((LAS float*)r_)[6] = (AL_); r_[7] = 0; } while (0)
        SETG(0, XBp, w + WS_WIN, ACTp, 0ull, 2 * FF, D, D, 0, 0, 1, 0.f);
        SETG(1, ACTp, w + WS_WOUT, XFp, XBp, D, FF, FF, 0, 1, 1, 0.5f);
        SETG(2, PBp, w + WS_WPG, ZBp, 0ull, D, 256, D, 256, 2, 1, 0.f);
        SETG(3, ZBp, w + WS_WPO, XFp, XBp, D, D, D, 0, 1, 1, 1.0f);
        SETG(4, XBp, w + WS_WIN + WIN_BYTES, ACTp, 0ull, 2 * FF, D, D, 0, 0, 1, 1.f);
        SETG(5, ACTp, w + WS_WOUT + WOUT_BYTES, XFp, XBp, D, FF, FF, 0, 1, 1, 0.5f);
        SETG(6, XBp, w + WS_WKV, w + WS_KB, w + WS_VB, 2 * D, D, D, 0, 3, 0, 0.f);
        SETG(7, XBp, w + WS_WIN + 2 * WIN_BYTES, ACTp, 0ull, 2 * FF, D, D, 0, 0, 1, 2.f);
        SETG(8, ACTp, w + WS_WOUT + 2 * WOUT_BYTES, XFp, XBp, D, FF, FF, 0, 1, 1, 0.5f);
        SETG(9, XBp, w + WS_WQ, w + WS_QB, 0ull, NQ, D, D, 0, 4, 1, 0.f);
        SETG(10, PBp, w + WS_WO, XFp, XBp, D, D, D, 0, 1, 1, 1.0f);
        SETG(11, XBp, w + WS_WIN + 3 * WIN_BYTES, ACTp, 0ull, 2 * FF, D, D, 0, 0, 1, 3.f);
        SETG(12, ACTp, w + WS_WOUT + 3 * WOUT_BYTES, XFp, XBp, D, FF, FF, 0, 1, 1, 0.5f);
#undef SETG
    }
    __syncthreads();

    {
        const int gw = bx * 8 + wave, NGW = G * 8;
        const size_t gtid = (size_t)bx * 512 + tid, GT = (size_t)G * 512;
        GAS unsigned char* ws = (GAS unsigned char*)P.ws;
        GAS bf16_t* Win = (GAS bf16_t*)(ws + WS_WIN); GAS bf16_t* Wout = (GAS bf16_t*)(ws + WS_WOUT); GAS bf16_t* Wpg = (GAS bf16_t*)(ws + WS_WPG);
        LAS float* scr = (LAS float*)(lds + wave * 16384);
        transpose_matrix(P.in[6], D, 2 * FF, Win, 1, P.in[5], nullptr, scr, gw, NGW, lane);
        transpose_matrix(P.in[10], D, 2 * FF, Win + WIN_E, 1, P.in[9], nullptr, scr, gw, NGW, lane);
        transpose_matrix(P.in[6] + WIN_E, D, 2 * FF, Win + 2 * WIN_E, 1, P.in[5] + D, nullptr, scr, gw, NGW, lane);
        transpose_matrix(P.in[10] + WIN_E, D, 2 * FF, Win + 3 * WIN_E, 1, P.in[9] + D, nullptr, scr, gw, NGW, lane);
        transpose_matrix(P.in[7], FF, D, Wout, 0, nullptr, nullptr, scr, gw, NGW, lane);
        transpose_matrix(P.in[11], FF, D, Wout + WOUT_E, 0, nullptr, nullptr, scr, gw, NGW, lane);
        transpose_matrix(P.in[7] + WOUT_E, FF, D, Wout + 2 * WOUT_E, 0, nullptr, nullptr, scr, gw, NGW, lane);
        transpose_matrix(P.in[11] + WOUT_E, FF, D, Wout + 3 * WOUT_E, 0, nullptr, nullptr, scr, gw, NGW, lane);
        for (int gi = 0; gi < 4; ++gi) transpose_matrix(P.in[12] + (size_t)gi * 65536, 256, 256, Wpg + (size_t)gi * 65536, 0, nullptr, P.in[13] + gi * 256, scr, gw, NGW, lane);
        transpose_matrix(P.in[14], D, D, (GAS bf16_t*)(ws + WS_WPO), 0, nullptr, nullptr, scr, gw, NGW, lane);
        transpose_matrix(P.in[16], D, 2 * D, (GAS bf16_t*)(ws + WS_WKV), 0, P.in[15], nullptr, scr, gw, NGW, lane);
        transpose_matrix(P.in[17], D, NQ, (GAS bf16_t*)(ws + WS_WQ), 0, P.in[8] + D, nullptr, scr, gw, NGW, lane);
        transpose_matrix(P.in[18], D, D, (GAS bf16_t*)(ws + WS_WO), 0, nullptr, nullptr, scr, gw, NGW, lane);
        {
            const GAS float* x_prompt = (const GAS float*)P.in[0]; const GAS float* x_sample = (const GAS float*)P.in[1];
            GAS bf16_t* XB = (GAS bf16_t*)(ws + WS_XB); GAS float* ssq = (GAS float*)(ws + WS_SSQ);
            for (int row0 = gw; row0 < MV; row0 += 4 * NGW) {
                f32x4 v[4][4];
#pragma unroll
                for (int q = 0; q < 4; ++q) { const int row = row0 + q * NGW; const int rc = row < MV ? row : MV - 1;
                    const GAS f32x4* xr = (const GAS f32x4*)(rc < MP ? x_prompt + (size_t)rc * D : x_sample + (size_t)(rc - MP) * D) + lane;
#pragma unroll
                    for (int j = 0; j < 4; ++j) v[q][j] = xr[64 * j]; }
#pragma unroll
                for (int q = 0; q < 4; ++q) { const int row = row0 + q * NGW;
                    float s = 0.f;
#pragma unroll
                    for (int j = 0; j < 4; ++j) s += (v[q][j][0] * v[q][j][0] + v[q][j][1] * v[q][j][1]) + (v[q][j][2] * v[q][j][2] + v[q][j][3] * v[q][j][3]);
                    s = wave_sum(s);
                    if (row < MV) {
                        GAS u32x2* bo = (GAS u32x2*)(XB + (size_t)row * D) + lane;
#pragma unroll
                        for (int j = 0; j < 4; ++j) { u32x2 w; w.x = cvt_pk_bf16(v[q][j][0], v[q][j][1]); w.y = cvt_pk_bf16(v[q][j][2], v[q][j][3]); bo[64 * j] = w; }
                        if (lane < 16) ssq[(size_t)row * 16 + lane] = lane == 0 ? s : 0.f;
                    }
                }
            }
        }
        {
            GAS float* rope = (GAS float*)(ws + WS_ROPE);
            for (size_t i = gtid; i < (size_t)(SEQ + 1) * 16; i += GT) {
                const int pi = (int)(i >> 4), fi = (int)(i & 15); const double pos = pi < SEQ ? (double)pi : 16384.0;
                double iv = P.invf[0];
#define IV(k) if (fi == k) iv = P.invf[k]
                IV(1); IV(2); IV(3); IV(4); IV(5); IV(6); IV(7); IV(8); IV(9); IV(10); IV(11); IV(12); IV(13); IV(14); IV(15);
#undef IV
                double s, c; sincos_d(pos * iv, s, c);
                rope[(size_t)pi * 32 + fi] = (float)c; rope[(size_t)pi * 32 + 16 + fi] = (float)s;
            }
        }
    }
    if (G == 0x7fffffff) grid.sync();
    GRID_BAR();

    for (int gi = 0; gi < NGEMM; ++gi) {
        if (gi == 2) {
            int t_ = threadIdx.x; asm volatile("" : "+v"(t_)); const int tid = t_, lane = tid & 63, wave = __builtin_amdgcn_readfirstlane(tid >> 6); (void)lane; (void)wave;
            GAS unsigned char* ws = ldp(lds, 21); GAS float* out = (GAS float*)ldp(lds, 20);
            const GAS float* mix_norm = (const GAS float*)ldp(lds, 8); const GAS float* state_pool = (const GAS float*)ldp(lds, 2);
            const GAS float* ssq = (const GAS float*)(ws + WS_SSQ); const GAS bf16_t* XB = (const GAS bf16_t*)(ws + WS_XB); GAS bf16_t* PBUF = (GAS bf16_t*)(ws + WS_PB);
#define LDH(r_) ({ const u32x2 q_ = *(const GAS u32x2*)(XB + (size_t)(r_) * D + 4 * cq); (f32x4){__uint_as_float(q_.x << 16), __uint_as_float(q_.x & 0xffff0000u), __uint_as_float(q_.y << 16), __uint_as_float(q_.y & 0xffff0000u)}; })
            LAS float* rr = (LAS float*)lds;
            for (int unit = bx; unit < MP / 64 + NS; unit += G) {
                __syncthreads();
                if (unit < MP / 64) {
                    const int R0 = unit * 64, b = R0 >> 13, t0 = R0 & (SEQ - 1);
                    if (tid < 80) { const int tt = tid - 16; float r = 0.f;
                        if (t0 + tt >= 0) { const GAS float* sp = ssq + (size_t)(R0 + tt) * 16; float s = 0.f;
#pragma unroll
                            for (int j = 0; j < 16; ++j) s += sp[j];
                            r = rsqrtf(s * (1.0f / D) + RMS_EPS); }
                        rr[tid] = r; }
                    __syncthreads();
                    const int cq = tid & 255, half = tid >> 8, gq = cq >> 6, w = 2 << gq;
                    const f32x4 gm = *(const GAS f32x4*)(mix_norm + 4 * cq);
                    const int s0 = half * 32;
                    f32x4 win = (f32x4){0.f, 0.f, 0.f, 0.f};
#define LDRAW(r_) (*(const GAS u32x2*)(XB + (size_t)(r_) * D + 4 * cq))
#define UNP2(q_) ((f32x4){__uint_as_float((q_).x << 16), __uint_as_float((q_).x & 0xffff0000u), __uint_as_float((q_).y << 16), __uint_as_float((q_).y & 0xffff0000u)})
                    {
                        u32x2 hv[15];
#pragma unroll
                        for (int i = 1; i < 16; ++i) { const int tt = s0 - i; hv[i - 1] = (i < w && t0 + tt >= 0) ? LDRAW(R0 + tt) : (u32x2){0u, 0u}; }
#pragma unroll
                        for (int i = 1; i < 16; ++i) { const int tt = s0 - i; if (i < w && t0 + tt >= 0) win += UNP2(hv[i - 1]) * rr[tt + 16] * gm; }
                    }
                    for (int tb = s0; tb < s0 + 32; tb += 8) {
                        u32x2 cv[8], ov[8];
#pragma unroll
                        for (int k = 0; k < 8; ++k) { cv[k] = LDRAW(R0 + tb + k); const int to = tb + k - w + 1; ov[k] = (t0 + to >= 0) ? LDRAW(R0 + to) : (u32x2){0u, 0u}; }
#pragma unroll
                        for (int k = 0; k < 8; ++k) { const int tt = tb + k;
                            const f32x4 hc = UNP2(cv[k]) * rr[tt + 16] * gm;
                            win += hc;
                            const int t = t0 + tt; const float inv = 1.0f / (float)(t + 1 < w ? t + 1 : w);
                            const f32x4 p = win * inv - hc;
                            u32x2 o; o.x = cvt_pk_bf16(p[0], p[1]); o.y = cvt_pk_bf16(p[2], p[3]);
                            *(GAS u32x2*)(PBUF + (size_t)(R0 + tt) * D + 4 * cq) = o;
                            if (t >= SEQ - PB) *(GAS f32x4*)(out + O_SPP + ((size_t)b * PB + (t - (SEQ - PB))) * D + 4 * cq) = hc;
                            const int to = tt - w + 1; if (t0 + to >= 0) win -= UNP2(ov[k]) * rr[to + 16] * gm; }
                    }
#undef UNP2
#undef LDRAW
                } else {
                    const int sb = unit - MP / 64, row = MP + sb;
                    if (tid < 256) {
                        const int cq = tid, gq = cq >> 6, w = 2 << gq;
                        const GAS float* sp = ssq + (size_t)row * 16; float s = 0.f;
#pragma unroll
                        for (int j = 0; j < 16; ++j) s += sp[j];
                        const float r = rsqrtf(s * (1.0f / D) + RMS_EPS);
                        const f32x4 gm = *(const GAS f32x4*)(mix_norm + 4 * cq);
                        const f32x4 hn = LDH(row) * r * gm;
                        f32x4 win = hn;
                        for (int i = 0; i < PB; ++i) {
                            const f32x4 pv = *(const GAS f32x4*)(state_pool + ((size_t)sb * PB + i) * D + 4 * cq);
                            if (i >= PB - (w - 1)) win += pv;
                            if (i >= 1) *(GAS f32x4*)(out + O_SPS + ((size_t)sb * PB + (i - 1)) * D + 4 * cq) = pv;
                        }
                        *(GAS f32x4*)(out + O_SPS + ((size_t)sb * PB + (PB - 1)) * D + 4 * cq) = hn;
                        const f32x4 p = win * (1.0f / (float)w) - hn;
                        u32x2 o; o.x = cvt_pk_bf16(p[0], p[1]); o.y = cvt_pk_bf16(p[2], p[3]);
                        *(GAS u32x2*)(PBUF + (size_t)row * D + 4 * cq) = o;
                    }
                }
            }
            GRID_BAR();
        }
        if (gi == 10) {
            {
                int t_ = threadIdx.x; asm volatile("" : "+v"(t_)); const int tid = t_, lane = tid & 63, wave = __builtin_amdgcn_readfirstlane(tid >> 6);
                GAS unsigned char* ws = ldp(lds, 21);
                const GAS bf16_t* KB = (const GAS bf16_t*)(ws + WS_KB); const GAS bf16_t* VB = (const GAS bf16_t*)(ws + WS_VB); const GAS bf16_t* QB = (const GAS bf16_t*)(ws + WS_QB);
                GAS bf16_t* OG = (GAS bf16_t*)(ws + WS_OG); GAS float* lse = (GAS float*)(ws + WS_LSE);
                const int qi = lane & 15, qd = lane >> 4;
                const int per = (6144 + G - 1) / G, u0 = bx * per, u1 = (u0 + per < 6144) ? u0 + per : 6144;
                u32x4 kr[4], vr[4]; bf16x8 qn[4];
#define DEC(u_, gq_, b_, h_, cls_, n_, dl_) const int gq_ = (u_) / 2048, b_ = ((u_) >> 9) & 3, h_ = ((u_) >> 6) & 7, blk_##u_ = (u_) & 63; const int dl_ = gq_ == 0 ? 1 : (gq_ == 1 ? 4 : 16); const int nbk_##u_ = 64 / dl_, cls_ = blk_##u_ / nbk_##u_, n_ = blk_##u_ % nbk_##u_
#define ISSUE(gq_, b_, h_, cls_, n_, dl_) do { \
                    _Pragma("unroll") for (int i = 0; i < 4; ++i) { const int c = tid + 512 * i, row = c >> 4, ch = c & 15; \
                        const size_t so = ((size_t)(b_) * SEQ + (size_t)((128 * (n_) + row) * (dl_) + (cls_))) * D + (h_) * HD + ch * 8; kr[i] = *(const GAS u32x4*)(KB + so); vr[i] = *(const GAS u32x4*)(VB + so); } \
                    { const size_t qrow_ = (size_t)(b_) * SEQ + (size_t)((128 * (n_) + 16 * wave + qi) * (dl_) + (cls_)); \
                      _Pragma("unroll") for (int s = 0; s < 4; ++s) qn[s] = *(const GAS bf16x8*)(QB + qrow_ * NQ + ((gq_) * 8 + (h_)) * HD + 32 * s + 8 * qd); } } while (0)
                int rot = 0; bool chained = false;
                { const int uu = u0 < 6144 ? u0 : 6143; DEC(uu, g0, b0, h0, c0, n0, d0); ISSUE(g0, b0, h0, c0, n0, d0); }
                for (int u = u0; u < u1; ++u) {
                    DEC(u, gq, b, h, cls, n, dl);
                    __syncthreads();
                    {
                        const unsigned rx = (unsigned)rot << 15;
#pragma unroll
                        for (int i = 0; i < 4; ++i) { const int c = tid + 512 * i, row = c >> 4, ch = c & 15;
                            const unsigned oo = (unsigned)kv_off(128 + row, ch) ^ rx; *(LAS u32x4*)(lds + oo) = kr[i]; *(LAS u32x4*)(lds + 65536 + oo) = vr[i];
                        }
                        if (!chained) {
#pragma unroll
                            for (int i = 0; i < 4; ++i) { const int c = tid + 512 * i, row = c >> 4, ch = c & 15;
                                u32x4 kp = (u32x4){0u, 0u, 0u, 0u}, vp = (u32x4){0u, 0u, 0u, 0u};
                                if (n > 0) { const size_t sp = ((size_t)b * SEQ + (size_t)((128 * (n - 1) + row) * dl + cls)) * D + h * HD + ch * 8; kp = *(const GAS u32x4*)(KB + sp); vp = *(const GAS u32x4*)(VB + sp); }
                                const unsigned op = (unsigned)kv_off(row, ch) ^ rx; *(LAS u32x4*)(lds + op) = kp; *(LAS u32x4*)(lds + 65536 + op) = vp; }
                        }
                    }
                    bf16x8 qf[4];
#pragma unroll
                    for (int s = 0; s < 4; ++s) qf[s] = qn[s];
                    __syncthreads();
                    const int rotc = rot;
                    { const int un = (u + 1 < u1) ? u + 1 : u;
                      DEC(un, g1, b1, h1, c1, n1, d1); const bool ch1 = (n1 != 0) && ((un & 63) != 0) && (un != u);
                      ISSUE(g1, b1, h1, c1, n1, d1);
                      chained = ch1; rot = ch1 ? (rot ^ 1) : 0; }
                    const unsigned rx = (unsigned)rotc << 15;
                    const int ii = 16 * wave + qi; const size_t qrow = (size_t)b * SEQ + (size_t)((128 * n + ii) * dl + cls);
                    const int kw = 16 * wave;
                    f32x4 Sx[9];
                    {
                        bf16x8 kf[2][4];
#pragma unroll
                        for (int s = 0; s < 4; ++s) kf[0][s] = *(const LAS bf16x8*)(lds + ((unsigned)kv_off(kw + qi, 4 * s + qd) ^ rx));
#pragma unroll
                        for (int j = 0; j < 9; ++j) {
                            if (j < 8) {
#pragma unroll
                                for (int s = 0; s < 4; ++s) kf[(j + 1) & 1][s] = *(const LAS bf16x8*)(lds + ((unsigned)kv_off(kw + 16 * (j + 1) + qi, 4 * s + qd) ^ rx));
                            }
                            f32x4 a = (f32x4){0.f, 0.f, 0.f, 0.f};
#pragma unroll
                            for (int s = 0; s < 4; ++s) a = __builtin_amdgcn_mfma_f32_16x16x32_bf16(kf[j & 1][s], qf[s], a, 0, 0, 0);
                            if (j == 0) {
#pragma unroll
                                for (int e = 0; e < 4; ++e) a[e] = (4 * qd + e >= qi) ? a[e] : -INFINITY; }
                            if (j == 8) {
#pragma unroll
                                for (int e = 0; e < 4; ++e) a[e] = (4 * qd + e <= qi) ? a[e] : -INFINITY; }
                            Sx[j] = a;
                        }
                    }
                    if (n == 0) {
#pragma unroll
                        for (int j = 0; j < 8; ++j) if (wave + j < 8) Sx[j] = (f32x4){-INFINITY, -INFINITY, -INFINITY, -INFINITY};
                    }
                    float mx = -INFINITY;
#pragma unroll
                    for (int kt = 0; kt < 9; ++kt) mx = fmaxf(mx, fmaxf(fmaxf(Sx[kt][0], Sx[kt][1]), fmaxf(Sx[kt][2], Sx[kt][3])));
                    mx = fmaxf(mx, __shfl_xor(mx, 16)); mx = fmaxf(mx, __shfl_xor(mx, 32));
                    float ls = 0.f;
#pragma unroll
                    for (int kt = 0; kt < 9; ++kt)
#pragma unroll
                        for (int e = 0; e < 4; ++e) { const float p = __builtin_amdgcn_exp2f(Sx[kt][e] - mx); Sx[kt][e] = p; ls += p; }
                    ls += __shfl_xor(ls, 16); ls += __shfl_xor(ls, 32);
                    f32x4 O[8];
#pragma unroll
                    for (int dt = 0; dt < 8; ++dt) O[dt] = (f32x4){0.f, 0.f, 0.f, 0.f};
                    const int q4 = qi >> 2, p4 = qi & 3, sw = (q4 << 2) | qd;
                    const unsigned vlane = 65536u + 256u * (unsigned)(4 * qd + q4) + 8u * (unsigned)(p4 & 1);
#define TRR(dst, addr) asm volatile("ds_read_b64_tr_b16 %0, %1" : "=&v"(dst) : "v"(addr) : "memory")
#define TRBATCH(i_, L_, H_) do { const int ks_ = (i_) >> 1, dh_ = (i_) & 1; const int tl_ = 2 * ks_, th_ = (2 * ks_ + 1 < 9) ? 2 * ks_ + 1 : 8; \
                        const unsigned blo_ = ((256u * (unsigned)(kw + 16 * tl_)) ^ rx) + vlane, bhi_ = ((256u * (unsigned)(kw + 16 * th_)) ^ rx) + vlane; \
                        _Pragma("unroll") for (int d4 = 0; d4 < 4; ++d4) { const int dt_ = 4 * dh_ + d4; const unsigned co_ = 16u * (unsigned)((2 * dt_ + (p4 >> 1)) ^ sw); const unsigned a0_ = blo_ + co_, a1_ = bhi_ + co_; TRR(L_[d4], a0_); TRR(H_[d4], a1_); } } while (0)
#define PVMMA(i_, L_, H_) do { const int ks_ = (i_) >> 1, dh_ = (i_) & 1; \
                        bf16x8 pf_; { u32x4 t_; t_.x = cvt_pk_bf16(Sx[2 * ks_][0], Sx[2 * ks_][1]); t_.y = cvt_pk_bf16(Sx[2 * ks_][2], Sx[2 * ks_][3]); \
                            if (2 * ks_ + 1 < 9) { t_.z = cvt_pk_bf16(Sx[(2 * ks_ + 1 < 9) ? 2 * ks_ + 1 : 8][0], Sx[(2 * ks_ + 1 < 9) ? 2 * ks_ + 1 : 8][1]); t_.w = cvt_pk_bf16(Sx[(2 * ks_ + 1 < 9) ? 2 * ks_ + 1 : 8][2], Sx[(2 * ks_ + 1 < 9) ? 2 * ks_ + 1 : 8][3]); } else { t_.z = 0u; t_.w = 0u; } \
                            pf_ = __builtin_bit_cast(bf16x8, t_); } \
                        _Pragma("unroll") for (int d4 = 0; d4 < 4; ++d4) { const int dt_ = 4 * dh_ + d4; const bf16x8 vf_ = (bf16x8){L_[d4][0], L_[d4][1], L_[d4][2], L_[d4][3], H_[d4][0], H_[d4][1], H_[d4][2], H_[d4][3]}; \
                            O[dt_] = __builtin_amdgcn_mfma_f32_16x16x32_bf16(vf_, pf_, O[dt_], 0, 0, 0); } } while (0)
#define TRWAIT(cnt_, L_, H_) asm volatile("s_waitcnt lgkmcnt(" #cnt_ ")" : "+v"(L_[0]), "+v"(L_[1]), "+v"(L_[2]), "+v"(L_[3]), "+v"(H_[0]), "+v"(H_[1]), "+v"(H_[2]), "+v"(H_[3]) :: "memory")
                    {
                        s16x4 la[4], ha[4], lb[4], hb[4];
                        TRBATCH(0, la, ha);
                        TRBATCH(1, lb, hb); TRWAIT(8, la, ha); PVMMA(0, la, ha);
                        TRBATCH(2, la, ha); TRWAIT(8, lb, hb); PVMMA(1, lb, hb);
                        TRBATCH(3, lb, hb); TRWAIT(8, la, ha); PVMMA(2, la, ha);
                        TRBATCH(4, la, ha); TRWAIT(8, lb, hb); PVMMA(3, lb, hb);
                        TRBATCH(5, lb, hb); TRWAIT(8, la, ha); PVMMA(4, la, ha);
                        TRBATCH(6, la, ha); TRWAIT(8, lb, hb); PVMMA(5, lb, hb);
                        TRBATCH(7, lb, hb); TRWAIT(8, la, ha); PVMMA(6, la, ha);
                        TRBATCH(8, la, ha); TRWAIT(8, lb, hb); PVMMA(7, lb, hb);
                        TRBATCH(9, lb, hb); TRWAIT(8, la, ha); PVMMA(8, la, ha);
                        TRWAIT(0, lb, hb); PVMMA(9, lb, hb);
                    }
#undef TRWAIT
#undef PVMMA
#undef TRBATCH
#undef TRR
                    const float inv = 1.0f / ls;
                    GAS bf16_t* od = OG + ((size_t)gq * MT + qrow) * D + h * HD + 4 * qd;
#pragma unroll
                    for (int dt = 0; dt < 8; ++dt) { u32x2 w; w.x = cvt_pk_bf16(O[dt][0] * inv, O[dt][1] * inv); w.y = cvt_pk_bf16(O[dt][2] * inv, O[dt][3] * inv); *(GAS u32x2*)(od + 16 * dt) = w; }
                    if (qd == 0) lse[((size_t)gq * MT + qrow) * 8 + h] = mx + __builtin_amdgcn_logf(ls);
                }
#undef ISSUE
#undef DEC
            }
            {
                int t_ = threadIdx.x; asm volatile("" : "+v"(t_)); const int tid = t_, lane = tid & 63, wave = __builtin_amdgcn_readfirstlane(tid >> 6);
                GAS unsigned char* ws = ldp(lds, 21); const GAS float* out = (const GAS float*)ldp(lds, 20);
                const GAS float* cache_k = (const GAS float*)ldp(lds, 3); const GAS float* cache_v = (const GAS float*)ldp(lds, 4);
                const GAS bf16_t* QB = (const GAS bf16_t*)(ws + WS_QB); GAS bf16_t* PBUF = (GAS bf16_t*)(ws + WS_PB);
                LAS float* sc = (LAS float*)lds;
                LAS f32x4* red = (LAS f32x4*)(lds + 2048);
                for (int unit = bx; unit < NS * NH; unit += G) {
                    const int b = unit >> 3, h = unit & 7;
                    __syncthreads();
                    const int l16 = lane & 15, kq = lane >> 4;
#pragma unroll
                    for (int pass = 0; pass < 13; ++pass) {
                        const int pi = pass * 32 + wave * 4 + kq, pc = pi < 387 ? pi : 386;
                        const int gq = pc / 129, j = pc % 129, dl = gq == 0 ? 1 : (gq == 1 ? 4 : 16);
                        const GAS float* kp = (j == 0) ? out + O_CKS + ((size_t)b * WMAX + (WMAX - 1)) * D : cache_k + ((size_t)b * WMAX + (WMAX - dl * j)) * D;
                        const f32x4 k0 = *(const GAS f32x4*)(kp + h * HD + 8 * l16), k1 = *(const GAS f32x4*)(kp + h * HD + 8 * l16 + 4);
                        const u32x4 qv = *(const GAS u32x4*)(QB + (size_t)(MP + b) * NQ + (gq * 8 + h) * HD + 8 * l16);
                        float s = k0[0] * __uint_as_float(qv.x << 16) + k0[1] * __uint_as_float(qv.x & 0xffff0000u) + k0[2] * __uint_as_float(qv.y << 16) + k0[3] * __uint_as_float(qv.y & 0xffff0000u)
                                + k1[0] * __uint_as_float(qv.z << 16) + k1[1] * __uint_as_float(qv.z & 0xffff0000u) + k1[2] * __uint_as_float(qv.w << 16) + k1[3] * __uint_as_float(qv.w & 0xffff0000u);
                        s += __shfl_xor(s, 1); s += __shfl_xor(s, 2); s += __shfl_xor(s, 4); s += __shfl_xor(s, 8);
                        if (l16 == 0 && pi < 387) sc[pi] = s;
                    }
                    __syncthreads();
                    if (wave == 0) {
                        float v[7]; float mx = -INFINITY;
#pragma unroll
                        for (int i = 0; i < 7; ++i) { const int pi = lane + 64 * i; v[i] = pi < 387 ? sc[pi] : -INFINITY; mx = fmaxf(mx, v[i]); }
                        mx = wave_max(mx); float ls = 0.f;
#pragma unroll
                        for (int i = 0; i < 7; ++i) { const int pi = lane + 64 * i; const float p = __builtin_amdgcn_exp2f(v[i] - mx); ls += p; if (pi < 387) sc[pi] = p; }
                        ls = wave_sum(ls);
                        if (lane == 0) sc[500] = 1.0f / ls;
                    }
                    __syncthreads();
                    {
                        const int part = tid >> 5, d4 = (tid & 31) * 4; f32x4 acc = (f32x4){0.f, 0.f, 0.f, 0.f};
#pragma unroll 5
                        for (int it = 0; it < 25; ++it) {
                            const int pi = part + 16 * it, pc = pi < 387 ? pi : 386;
                            const int gq = pc / 129, j = pc % 129, dl = gq == 0 ? 1 : (gq == 1 ? 4 : 16);
                            const GAS float* vp = (j == 0) ? out + O_CVS + ((size_t)b * WMAX + (WMAX - 1)) * D : cache_v + ((size_t)b * WMAX + (WMAX - dl * j)) * D;
                            const float p = pi < 387 ? sc[pc] : 0.f;
                            acc += *(const GAS f32x4*)(vp + h * HD + d4) * p;
                        }
                        red[part * 32 + (tid & 31)] = acc;
                    }
                    __syncthreads();
                    if (tid < 128) { const LAS float* rf = (const LAS float*)red; float o = 0.f;
#pragma unroll
                        for (int pt = 0; pt < 16; ++pt) o += rf[pt * 128 + tid];
                        o *= sc[500];
                        PBUF[(size_t)(MP + b) * D + h * HD + tid] = (bf16_t)(cvt_pk_bf16(o, 0.f) & 0xffffu); }
                }
            }
            GRID_BAR();
            {
                int t_ = threadIdx.x; asm volatile("" : "+v"(t_)); const int tid = t_, lane = tid & 63, wave = __builtin_amdgcn_readfirstlane(tid >> 6); (void)lane; (void)wave;
                GAS unsigned char* ws = ldp(lds, 21);
                const GAS bf16_t* OG = (const GAS bf16_t*)(ws + WS_OG); const GAS float* lse = (const GAS float*)(ws + WS_LSE); GAS bf16_t* PBUF = (GAS bf16_t*)(ws + WS_PB);
                const size_t gtid = (size_t)bx * 512 + tid, GT = (size_t)G * 512;
                constexpr size_t NIT = (size_t)MP * 128;
                size_t i = gtid;
                for (; i + 3 * GT < NIT; i += 4 * GT) {
                    float l[4][3]; u32x4 og[4][3];
#pragma unroll
                    for (int q = 0; q < 4; ++q) { const size_t it = i + q * GT, row = it >> 7; const int ch = (int)(it & 127), h = ch >> 4;
#pragma unroll
                        for (int g3 = 0; g3 < 3; ++g3) { l[q][g3] = lse[((size_t)g3 * MT + row) * 8 + h]; og[q][g3] = *(const GAS u32x4*)(OG + ((size_t)g3 * MT + row) * D + ch * 8); } }
#pragma unroll
                    for (int q = 0; q < 4; ++q) { const size_t it = i + q * GT, row = it >> 7; const int ch = (int)(it & 127);
                        const float m = fmaxf(l[q][0], fmaxf(l[q][1], l[q][2]));
                        float w0 = __builtin_amdgcn_exp2f(l[q][0] - m), w1 = __builtin_amdgcn_exp2f(l[q][1] - m), w2 = __builtin_amdgcn_exp2f(l[q][2] - m);
                        const float inv = 1.0f / (w0 + w1 + w2); w0 *= inv; w1 *= inv; w2 *= inv;
                        u32x4 o;
#pragma unroll
                        for (int e = 0; e < 4; ++e) {
                            const float lo = w0 * __uint_as_float(og[q][0][e] << 16) + w1 * __uint_as_float(og[q][1][e] << 16) + w2 * __uint_as_float(og[q][2][e] << 16);
                            const float hi = w0 * __uint_as_float(og[q][0][e] & 0xffff0000u) + w1 * __uint_as_float(og[q][1][e] & 0xffff0000u) + w2 * __uint_as_float(og[q][2][e] & 0xffff0000u);
                            o[e] = cvt_pk_bf16(lo, hi);
                        }
                        *(GAS u32x4*)(PBUF + row * D + ch * 8) = o; }
                }
                for (; i < NIT; i += GT) {
                    const size_t row = i >> 7; const int ch = (int)(i & 127), h = ch >> 4;
                    const float l0 = lse[((size_t)0 * MT + row) * 8 + h], l1 = lse[((size_t)1 * MT + row) * 8 + h], l2 = lse[((size_t)2 * MT + row) * 8 + h];
                    const float m = fmaxf(l0, fmaxf(l1, l2));
                    float w0 = __builtin_amdgcn_exp2f(l0 - m), w1 = __builtin_amdgcn_exp2f(l1 - m), w2 = __builtin_amdgcn_exp2f(l2 - m);
                    const float inv = 1.0f / (w0 + w1 + w2); w0 *= inv; w1 *= inv; w2 *= inv;
                    const u32x4 a = *(const GAS u32x4*)(OG + ((size_t)0 * MT + row) * D + ch * 8), bb = *(const GAS u32x4*)(OG + ((size_t)1 * MT + row) * D + ch * 8), c = *(const GAS u32x4*)(OG + ((size_t)2 * MT + row) * D + ch * 8);
                    u32x4 o;
#pragma unroll
                    for (int e = 0; e < 4; ++e) {
                        const float lo = w0 * __uint_as_float(a[e] << 16) + w1 * __uint_as_float(bb[e] << 16) + w2 * __uint_as_float(c[e] << 16);
                        const float hi = w0 * __uint_as_float(a[e] & 0xffff0000u) + w1 * __uint_as_float(bb[e] & 0xffff0000u) + w2 * __uint_as_float(c[e] & 0xffff0000u);
                        o[e] = cvt_pk_bf16(lo, hi);
                    }
                    *(GAS u32x4*)(PBUF + row * D + ch * 8) = o;
                }
            }
            GRID_BAR();
        }
        {
            const LAS unsigned* wv = (const LAS unsigned*)(lds + TAB_OFF + 256 + gi * 64);
            unsigned v[16];
#pragma unroll
            for (int j = 0; j < 16; ++j) v[j] = __builtin_amdgcn_readfirstlane(wv[j]);
#define U64(a, b) (((unsigned long long)(b) << 32) | (a))
            pg8::Gemm g{(const GAS bf16_t*)U64(v[0], v[1]), (const GAS bf16_t*)U64(v[2], v[3]), MP, (int)v[8], (int)v[9], (int)v[10], (int)v[11]};
            GAS unsigned char* ws = ldp(lds, 21);
            EpiAll E{(int)v[12], (GAS void*)U64(v[4], v[5]), (GAS void*)U64(v[6], v[7]), (GAS float*)(ws + WS_SSQ), (const GAS float*)(ws + WS_ROPE), (GAS float*)ldp(lds, 20), __uint_as_float(v[14]), lds};
#undef U64
            { const int item = G - 1 - bx; if (item < (g.N >> 6)) skinny_item(lds, g, E, item); }
            pg8::StaticOrder S; S.init(MP, g.N, G, bx);
            pg8::gemm_phase(lds, g, S, E);
            if (v[13]) GRID_BAR();
        }
    }
    {
        int t_ = threadIdx.x; asm volatile("" : "+v"(t_)); const int tid = t_, lane = tid & 63, wave = __builtin_amdgcn_readfirstlane(tid >> 6);
        GAS unsigned char* ws = ldp(lds, 21); GAS float* out = (GAS float*)ldp(lds, 20); const GAS float* final_norm = (const GAS float*)ldp(lds, 19);
        const GAS float* ssq = (const GAS float*)(ws + WS_SSQ); const GAS bf16_t* XB = (const GAS bf16_t*)(ws + WS_XB);
        const int gw = bx * 8 + wave, NGW = G * 8;
        const GAS f32x4* gn = (const GAS f32x4*)final_norm + lane;
        if ((128 * 22) % G != 0) {
            constexpr unsigned per_b = (unsigned)(WMAX - 1) * D / 4, full_b = (unsigned)WMAX * D / 4, tot = 2u * NS * per_b;
            const GAS f32x4* sk = (const GAS f32x4*)ldp(lds, 3); const GAS f32x4* sv = (const GAS f32x4*)ldp(lds, 4);
            GAS f32x4* dk = (GAS f32x4*)(out + O_CKS); GAS f32x4* dv = (GAS f32x4*)(out + O_CVS);
            for (unsigned j = (unsigned)bx * 512u + (unsigned)tid; j < tot; j += (unsigned)G * 512u) { const unsigned ck = j / per_b, r = j - ck * per_b, b = ck >> 1;
                ((ck & 1) ? dv : dk)[(size_t)b * full_b + r] = ((ck & 1) ? sv : sk)[(size_t)b * full_b + (D / 4) + r]; }
        }
        const f32x4 g0 = gn[0], g1 = gn[64], g2 = gn[128], g3 = gn[192];
#define UNPK(q_) ((f32x4){__uint_as_float((q_).x << 16), __uint_as_float((q_).x & 0xffff0000u), __uint_as_float((q_).y << 16), __uint_as_float((q_).y & 0xffff0000u)})
        int row = gw;
        for (; row + 3 * NGW < MV; row += 4 * NGW) {
            f32x4 s4[4]; u32x2 q[4][4];
#pragma unroll
            for (int b4 = 0; b4 < 4; ++b4) { const int rw = row + b4 * NGW; s4[b4] = *(const GAS f32x4*)(ssq + (size_t)rw * 16 + 4 * (lane & 3));
                const GAS u32x2* xr = (const GAS u32x2*)(XB + (size_t)rw * D) + lane; q[b4][0] = xr[0]; q[b4][1] = xr[64]; q[b4][2] = xr[128]; q[b4][3] = xr[192]; }
#pragma unroll
            for (int b4 = 0; b4 < 4; ++b4) { const int rw = row + b4 * NGW;
                float s = (s4[b4][0] + s4[b4][1]) + (s4[b4][2] + s4[b4][3]); s += __shfl_xor(s, 1); s += __shfl_xor(s, 2);
                const float r = rsqrtf(s * (1.0f / D) + RMS_EPS);
                GAS f32x4* yo = (GAS f32x4*)(out + (size_t)rw * D) + lane;
                __builtin_nontemporal_store(UNPK(q[b4][0]) * r * g0, yo); __builtin_nontemporal_store(UNPK(q[b4][1]) * r * g1, yo + 64);
                __builtin_nontemporal_store(UNPK(q[b4][2]) * r * g2, yo + 128); __builtin_nontemporal_store(UNPK(q[b4][3]) * r * g3, yo + 192); }
        }
        for (; row < MV; row += NGW) {
            const f32x4 s4 = *(const GAS f32x4*)(ssq + (size_t)row * 16 + 4 * (lane & 3));
            float s = (s4[0] + s4[1]) + (s4[2] + s4[3]); s += __shfl_xor(s, 1); s += __shfl_xor(s, 2);
            const float r = rsqrtf(s * (1.0f / D) + RMS_EPS);
            const GAS u32x2* xr = (const GAS u32x2*)(XB + (size_t)row * D) + lane;
            GAS f32x4* yo = (GAS f32x4*)(out + (size_t)row * D) + lane;
            const u32x2 q0 = xr[0], q1 = xr[64], q2 = xr[128], q3 = xr[192];
            __builtin_nontemporal_store(UNPK(q0) * r * g0, yo); __builtin_nontemporal_store(UNPK(q1) * r * g1, yo + 64);
            __builtin_nontemporal_store(UNPK(q2) * r * g2, yo + 128); __builtin_nontemporal_store(UNPK(q3) * r * g3, yo + 192);
#undef UNPK
        }
    }
}

extern "C" void kernel_launch(void* const* d_in, const int* in_sizes, int n_in, void* d_out, int out_size, void* d_ws, size_t ws_size, hipStream_t stream) {
    static int grid = 0;
    if (grid == 0) {
        if (n_in != 20 || ws_size < WS_END) { fprintf(stderr, "kernel_launch: unexpected n_in %d / ws %zu (need %zu)\n", n_in, ws_size, (size_t)WS_END); grid = -1; return; }
        int dev = 0, cus = 0, per_cu = 0;
        hipGetDevice(&dev); hipDeviceGetAttribute(&cus, hipDeviceAttributeMultiprocessorCount, dev);
        hipFuncSetAttribute((const void*)yoco_fwd, hipFuncAttributeMaxDynamicSharedMemorySize, LDS_BYTES);
        hipOccupancyMaxActiveBlocksPerMultiprocessor(&per_cu, (const void*)yoco_fwd, 512, LDS_BYTES);
        if (per_cu < 1) { fprintf(stderr, "kernel_launch: occupancy query says %d blocks/CU\n", per_cu); per_cu = 1; }
        (void)hipGetLastError();
        grid = cus * 1;
    }
    if (grid < 0) return;
    Params p{};
    for (int i = 0; i < 20; ++i) p.in[i] = (const float*)d_in[i];
    p.out = (float*)d_out; p.ws = (unsigned char*)d_ws;
    static const double invf[16] = {1.0, 0.44036660267178046, 0.19392274474868576, 0.08539710028576561, 0.03760603093086393, 0.016560440080994446, 0.007292664737217109, 0.003211445994752591,
                                    0.001414213562373095, 0.000622772421914596, 0.0002742481756762073, 0.00012076973741146504, 5.318295896944988e-05, 2.341999896140934e-05, 1.031338537721246e-05, 4.5416704806078695e-06};
    for (int i = 0; i < 16; ++i) p.invf[i] = invf[i];
    (void)hipMemsetAsync(d_ws, 0, 16384, stream);
    void* args[] = {&p};
    hipError_t e = hipLaunchCooperativeKernel((const void*)yoco_fwd, dim3(grid), dim3(512), args, LDS_BYTES, stream);
    if (e != hipSuccess) fprintf(stderr, "cooperative launch failed: %s (grid %d)\n", hipGetErrorString(e), grid);
}
```

```cpp
#include <hip/hip_runtime.h>
#include <hip/hip_cooperative_groups.h>
#include <cstdio>
#include <cstdint>
namespace cg = cooperative_groups;

#define LAS __attribute__((address_space(3)))
#if defined(__HIP_DEVICE_COMPILE__)
#define GAS __attribute__((address_space(1)))
#else
#define GAS
#endif
typedef unsigned short bf16_t;
typedef short bf16x8 __attribute__((ext_vector_type(8)));
typedef short s16x4 __attribute__((ext_vector_type(4)));
typedef float f32x4 __attribute__((ext_vector_type(4)));
typedef float f32x2 __attribute__((ext_vector_type(2)));
typedef unsigned u32x4 __attribute__((ext_vector_type(4)));
typedef unsigned u32x2 __attribute__((ext_vector_type(2)));

constexpr int D = 1024, FF = 2816, NB = 4, SEQ = 8192, MP = NB * SEQ  , NS = 32  ;
constexpr int MT = MP + 256;
constexpr int MV = MP + NS;
constexpr int NH = 8, HD = 128, WMAX = 2048, PB = 15;
constexpr int NQ = 3 * D;
constexpr float RMS_EPS = 1e-6f;
constexpr float QSCALE = 0.08838834764831845f * 1.4426950408889634f;

constexpr size_t O_YP = 0, O_YS = (size_t)MP * D, O_SPP = O_YS + (size_t)NS * D, O_SPS = O_SPP + (size_t)NB * PB * D,
                 O_CKP = O_SPS + (size_t)NS * PB * D, O_CVP = O_CKP + (size_t)NB * WMAX * D, O_CKS = O_CVP + (size_t)NB * WMAX * D,
                 O_CVS = O_CKS + (size_t)NS * WMAX * D;

constexpr size_t MiB = 1u << 20;
constexpr size_t WS_WIN = 1 * MiB;
constexpr size_t WIN_BYTES = (size_t)2 * FF * D * 2;
constexpr size_t WS_WOUT = WS_WIN + 4 * WIN_BYTES;
constexpr size_t WOUT_BYTES = (size_t)D * FF * 2;
constexpr size_t WS_WPG = WS_WOUT + 4 * WOUT_BYTES;
constexpr size_t WS_WPO = WS_WPG + (size_t)D * 256 * 2;
constexpr size_t WS_WKV = WS_WPO + (size_t)D * D * 2;
constexpr size_t WS_WQ = WS_WKV + (size_t)2 * D * D * 2;
constexpr size_t WS_WO = WS_WQ + (size_t)NQ * D * 2;
constexpr size_t WS_ROPE = WS_WO + (size_t)D * D * 2;
constexpr size_t WS_SSQ = WS_ROPE + (size_t)8200 * 32 * 4;
constexpr size_t WS_LSE = WS_SSQ + (size_t)MT * 16 * 4;
constexpr size_t WS_XF = (WS_LSE + (size_t)3 * MT * 8 * 4 + 4095) & ~(size_t)4095;
constexpr size_t WS_XB = WS_XF + (size_t)MT * D * 4;
constexpr size_t WS_ACT = WS_XB + (size_t)MT * D * 2;
constexpr size_t WS_PB = WS_ACT + (size_t)MT * FF * 2;
constexpr size_t WS_ZB = WS_PB + (size_t)MT * D * 2;
constexpr size_t WS_KB = WS_ZB + (size_t)MT * D * 2;
constexpr size_t WS_VB = WS_KB + (size_t)MT * D * 2;
constexpr size_t WS_QB = WS_VB + (size_t)MT * D * 2;
constexpr size_t WS_OG = WS_QB + (size_t)MT * NQ * 2;
constexpr size_t WS_END = WS_OG + (size_t)3 * MT * D * 2;

constexpr int LDS_BYTES = 147456;

struct Params {
    const float* in[20];
    float* out;
    unsigned char* ws;
    double invf[16];
};

__device__ __forceinline__ unsigned cvt_pk_bf16(float lo, float hi) { unsigned r; asm volatile("v_cvt_pk_bf16_f32 %0, %1, %2" : "=v"(r) : "v"(lo), "v"(hi)); return r; }
__device__ __forceinline__ float bf2f(unsigned short b) { return __uint_as_float((unsigned)b << 16); }
__device__ __forceinline__ float wave_sum(float v) {
#pragma unroll
    for (int o = 1; o < 64; o <<= 1) v += __shfl_xor(v, o);
    return v;
}
__device__ __forceinline__ float wave_max(float v) {
#pragma unroll
    for (int o = 1; o < 64; o <<= 1) v = fmaxf(v, __shfl_xor(v, o));
    return v;
}

namespace pg8 {
constexpr int BM = 256, BK = 64, HALF = 128, HTB = HALF * BK * 2, STAGE_BYTES = 8 * HTB, NXCD = 8, WGM = 4;
__host__ __device__ __forceinline__ int lds_byte(int r, int c) { const int st = (r >> 4) * 2 + (c >> 5), rr = r & 15, cc = c & 31, ob = rr * 64 + cc * 2; return st * 1024 + (ob ^ (((ob >> 9) & 1) << 5)); }
__host__ __device__ __forceinline__ void stage_rc(int b, int& R, int& C) { const int st = b / 1024, sb = b % 1024, swz = sb ^ (((sb >> 9) & 1) << 5); R = (st >> 1) * 16 + swz / 64; C = (st & 1) * 32 + (swz % 64) / 2; }
__host__ __device__ __forceinline__ int perm32(int rho) { const int n = rho >> 4, i = rho & 15; return 8 * (i >> 2) + 4 * n + (i & 3); }

struct Unit { int pm, pn, ui; };
struct Gemm { const GAS bf16_t* A; const GAS bf16_t* Bt; int M, N, K, lda, acol; };

struct StaticOrder {
    int nM, nN, nwg, G, c;
    __device__ void init(int M, int N, int G_, int c_) { nM = M / BM; nN = N / BM; nwg = nM * nN; G = G_; c = c_; }
    __device__ bool next(int i, Unit& u) const {
        const long L = (long)i * G + c; if (L >= nwg) return false;
        int wgid = (int)L; { const int q = nwg / NXCD, r = nwg % NXCD, xcd = wgid % NXCD, off = wgid / NXCD; wgid = (xcd < r ? xcd * (q + 1) : r * (q + 1) + (xcd - r) * q) + off; }
        const int nig = WGM * nN, gid = wgid / nig, fm = gid * WGM, gsz = (nM - fm) < WGM ? (nM - fm) : WGM;
        u.pm = fm + ((wgid % nig) % gsz); u.pn = (wgid % nig) / gsz; u.ui = i; return true;
    }
};

template <class Epi>
__device__ __forceinline__ void gemm_phase(LAS unsigned char* lds, const Gemm g, const StaticOrder& S, const Epi& E) {
    const bool PERMR = E.perm();
    const int tid = threadIdx.x, wid = __builtin_amdgcn_readfirstlane(tid >> 6), lane = tid & 63, wr = wid >> 2, wc = wid & 3, fr = lane & 15, fq = lane >> 4;
    const int K = g.K, nt = K / BK;
    unsigned voffA[2], voffB[2];
#pragma unroll
    for (int i = 0; i < 2; ++i) { int R, C; stage_rc(tid * 16 + i * 8192, R, C); const int Rb = PERMR ? ((R & ~31) + perm32(R & 31)) : R;
        voffA[i] = (unsigned)(R * g.lda + C) * 2u; voffB[i] = (unsigned)(Rb * K + C) * 2u; }
    const size_t kstep = (size_t)(BK * 2);
    const size_t hstepA = (size_t)HALF * g.lda * 2, hstepB = (size_t)HALF * K * 2;
    const unsigned ldsw = (unsigned)wid * 1024u;
    const int aoff = lds_byte(wr * 64 + fr, fq * 8), boff = lds_byte(wc * 32 + fr, fq * 8);
#define PG8_SA(b, h) (((b) * 2 + (h)) * HTB)
#define PG8_SB(b, h) ((4 + (b) * 2 + (h)) * HTB)
#define PG8_STAGE(bufoff, gbase, voff) do { _Pragma("unroll") for (int _i = 0; _i < 2; ++_i) \
        __builtin_amdgcn_global_load_lds((const unsigned*)((const char*)(gbase) + (voff)[_i]), (LAS unsigned*)(lds + (bufoff) + ldsw + _i * 8192), 16, 0, 0); } while (0)
#define PG8_LDA(dst, b, h) do { _Pragma("unroll") for (int m = 0; m < 4; ++m) _Pragma("unroll") for (int k = 0; k < 2; ++k) dst[m][k] = *(const LAS bf16x8*)(lds + PG8_SA(b, h) + aoff + m * 2048 + k * 1024); } while (0)
#define PG8_LDB(dst, b, h) do { _Pragma("unroll") for (int n = 0; n < 2; ++n) _Pragma("unroll") for (int k = 0; k < 2; ++k) dst[n][k] = *(const LAS bf16x8*)(lds + PG8_SB(b, h) + boff + n * 2048 + k * 1024); } while (0)
#define PG8_MMA(ai, bj, At, Bt) do { __builtin_amdgcn_s_setprio(1); _Pragma("unroll") for (int m = 0; m < 4; ++m) _Pragma("unroll") for (int n = 0; n < 2; ++n) _Pragma("unroll") for (int k = 0; k < 2; ++k) \
        acc[ai][bj][m][n] = __builtin_amdgcn_mfma_f32_16x16x32_bf16(Bt[n][k], At[m][k], acc[ai][bj][m][n], 0, 0, 0); __builtin_amdgcn_s_setprio(0); } while (0)
#define PG8_WAIT_V(n) asm volatile("s_waitcnt vmcnt(" #n ")" ::: "memory")
#define PG8_WAIT_L(n) asm volatile("s_waitcnt lgkmcnt(" #n ")" ::: "memory")
#define PG8_BAR __builtin_amdgcn_s_barrier()
#define PG8_SCHED __builtin_amdgcn_sched_barrier(0)
    Unit cur, nxt; int ui = 0;
    if (!S.next(0, cur)) return;
    f32x4 acc[2][2][4][2];
#pragma unroll
    for (int a = 0; a < 2; ++a)
#pragma unroll
        for (int b = 0; b < 2; ++b)
#pragma unroll
            for (int m = 0; m < 4; ++m)
#pragma unroll
                for (int n = 0; n < 2; ++n) acc[a][b][m][n] = (f32x4){0.f, 0.f, 0.f, 0.f};
    bf16x8 At[4][2], B0[2][2], B1[2][2];
    const char* cA = (const char*)g.A + (size_t)cur.pm * 2 * hstepA + (size_t)cur.pn * g.acol * 2;
    const char* cB = (const char*)g.Bt + (size_t)cur.pn * 2 * hstepB;
    PG8_STAGE(PG8_SB(0, 0), cB, voffB); PG8_STAGE(PG8_SB(0, 1), cB + hstepB, voffB); PG8_STAGE(PG8_SA(0, 0), cA, voffA); PG8_STAGE(PG8_SA(0, 1), cA + hstepA, voffA);
    if (wr == 1) PG8_BAR;
    PG8_WAIT_V(2); PG8_BAR;
    PG8_STAGE(PG8_SB(1, 0), cB + kstep, voffB); PG8_STAGE(PG8_SA(1, 0), cA + kstep, voffA); PG8_STAGE(PG8_SB(1, 1), cB + hstepB + kstep, voffB);
    PG8_WAIT_V(6); PG8_BAR;
    for (;;) {
        const bool has_next = S.next(ui + 1, nxt);
        const char* nA = has_next ? (const char*)g.A + (size_t)nxt.pm * 2 * hstepA + (size_t)nxt.pn * g.acol * 2 : cA;
        const char* nB = has_next ? (const char*)g.Bt + (size_t)nxt.pn * 2 * hstepB : cB;
        for (int t = 0; t < nt; t += 2) {
            const bool last = (t == nt - 2);
            const char* a1 = cA + (size_t)(t + 1) * kstep;
            const char* a2 = last ? nA : cA + (size_t)(t + 2) * kstep; const char* b2 = last ? nB : cB + (size_t)(t + 2) * kstep;
            const char* a3 = a2 + kstep; const char* b3 = b2 + kstep;
            PG8_LDB(B0, 0, 0); PG8_LDB(B1, 0, 1); PG8_SCHED; PG8_LDA(At, 0, 0); PG8_STAGE(PG8_SA(1, 1), a1 + hstepA, voffA);
            PG8_WAIT_V(8); PG8_WAIT_L(0); PG8_BAR; PG8_MMA(0, 0, At, B0); PG8_MMA(0, 1, At, B1); PG8_BAR; PG8_SCHED;
            PG8_LDA(At, 0, 1); PG8_STAGE(PG8_SB(0, 0), b2, voffB); PG8_STAGE(PG8_SB(0, 1), b2 + hstepB, voffB); PG8_STAGE(PG8_SA(0, 0), a2, voffA);
            PG8_WAIT_V(8); PG8_WAIT_L(0); PG8_BAR; PG8_MMA(1, 0, At, B0); PG8_MMA(1, 1, At, B1); PG8_BAR; PG8_SCHED;
            PG8_LDB(B0, 1, 0); PG8_LDB(B1, 1, 1); PG8_SCHED; PG8_LDA(At, 1, 0); PG8_STAGE(PG8_SA(0, 1), a2 + hstepA, voffA);
            PG8_WAIT_V(8); PG8_WAIT_L(0); PG8_BAR; PG8_MMA(0, 0, At, B0); PG8_MMA(0, 1, At, B1); PG8_BAR; PG8_SCHED;
            PG8_LDA(At, 1, 1); PG8_STAGE(PG8_SB(1, 0), b3, voffB); PG8_STAGE(PG8_SB(1, 1), b3 + hstepB, voffB); PG8_STAGE(PG8_SA(1, 0), a3, voffA);
            PG8_WAIT_V(8); PG8_WAIT_L(0); PG8_BAR; PG8_MMA(1, 0, At, B0); PG8_MMA(1, 1, At, B1); PG8_BAR; PG8_SCHED;
        }
        if (wr == 0) PG8_BAR;
        E(acc, cur, wr, wc, fr, fq);
        if (!has_next) break;
#pragma unroll
        for (int a = 0; a < 2; ++a)
#pragma unroll
            for (int b = 0; b < 2; ++b)
#pragma unroll
                for (int m = 0; m < 4; ++m)
#pragma unroll
                    for (int n = 0; n < 2; ++n) acc[a][b][m][n] = (f32x4){0.f, 0.f, 0.f, 0.f};
        cur = nxt; cA = nA; cB = nB; ++ui;
        if (wr == 1) PG8_BAR;
    }
    PG8_WAIT_V(0);
    PG8_BAR;
#undef PG8_SA
#undef PG8_SB
#undef PG8_STAGE
#undef PG8_LDA
#undef PG8_LDB
#undef PG8_MMA
#undef PG8_WAIT_V
#undef PG8_WAIT_L
#undef PG8_BAR
#undef PG8_SCHED
}
}
using pg8::Unit;

__device__ __forceinline__ float row_rs(const GAS float* ssq, int row, int fq) {
    const f32x4 v = *(const GAS f32x4*)(ssq + (size_t)row * 16 + fq * 4);
    float s = (v[0] + v[1]) + (v[2] + v[3]);
    s += __shfl_xor(s, 16); s += __shfl_xor(s, 32);
    return rsqrtf(s * (1.0f / D) + RMS_EPS);
}
__device__ __forceinline__ float silu_mul(float g, float u) { const float e = __builtin_amdgcn_exp2f(-g * 1.4426950408889634f); return g * __builtin_amdgcn_rcpf(1.0f + e) * u; }

constexpr int TAB_OFF_C = 131072;
struct EpiAll {
    int kind;
    GAS void* p0; GAS void* p1; GAS float* ssq; const GAS float* rope; GAS float* out; float alpha;
    LAS unsigned char* ldsb;
    __device__ __forceinline__ bool perm() const { return kind < 3 || kind == 5; }
    template <int NAI, int NM>
    __device__ __forceinline__ void swiglu(const f32x4 (&acc)[2][2][4][2], const Unit& u, int wr, int wc, int fr, int fq) const {
        GAS bf16_t* O = (GAS bf16_t*)p0;
        const int row0 = u.pm * 256 + wr * 64 + fr, col0 = u.pn * 128 + wc * 32 + 8 * fq;
        f32x4 cpv[6]; GAS f32x4* cpd[6];
        const bool cp_on = (NAI == 2) && ((128u * 22u) % gridDim.x == 0u);
        if (NAI == 2 && cp_on) {
            constexpr unsigned per_b = (unsigned)(WMAX - 1) * D / 4, full_b = (unsigned)WMAX * D / 4, tot = 2u * NS * per_b;
            const LAS unsigned* t = (const LAS unsigned*)(ldsb + TAB_OFF_C);
            const unsigned long long pk = ((unsigned long long)(unsigned)__builtin_amdgcn_readfirstlane(t[7]) << 32) | (unsigned long long)(unsigned)__builtin_amdgcn_readfirstlane(t[6]);
            const unsigned long long pv = ((unsigned long long)(unsigned)__builtin_amdgcn_readfirstlane(t[9]) << 32) | (unsigned long long)(unsigned)__builtin_amdgcn_readfirstlane(t[8]);
            const GAS f32x4* sk = (const GAS f32x4*)pk; const GAS f32x4* sv = (const GAS f32x4*)pv;
            GAS f32x4* dk = (GAS f32x4*)(out + O_CKS); GAS f32x4* dv = (GAS f32x4*)(out + O_CVS);
            const unsigned Gn = gridDim.x, upw = (128u * 22u + Gn - 1u) / Gn;
            const unsigned chunk = ((unsigned)alpha * upw + (unsigned)u.ui) * Gn + blockIdx.x;
#pragma unroll
            for (int k = 0; k < 6; ++k) { unsigned j = chunk * 3072u + threadIdx.x + 512u * (unsigned)k; const bool ok = j < tot; j = ok ? j : 0u;
                const unsigned ck = j / per_b, r = j - ck * per_b, b = ck >> 1;
                cpv[k] = __builtin_nontemporal_load(((ck & 1) ? sv : sk) + (size_t)b * full_b + (D / 4) + r);
                cpd[k] = ok ? ((ck & 1) ? dv : dk) + (size_t)b * full_b + r : (GAS f32x4*)nullptr; }
        }
#pragma unroll
        for (int ai = 0; ai < NAI; ++ai)
#pragma unroll
            for (int m = 0; m < NM; ++m) {
                const int row = row0 + ai * 128 + m * 16; const float r = row_rs(ssq, row, fq);
                const float r2 = r * r, cneg = r * -1.4426950408889634f;
                float o[8];
#pragma unroll
                for (int n = 0; n < 2; ++n)
#pragma unroll
                    for (int e = 0; e < 4; ++e) { const float g = acc[ai][0][m][n][e], uu = acc[ai][1][m][n][e];
                        o[n * 4 + e] = (g * uu) * r2 * __builtin_amdgcn_rcpf(1.0f + __builtin_amdgcn_exp2f(g * cneg)); }
                u32x4 w; w.x = cvt_pk_bf16(o[0], o[1]); w.y = cvt_pk_bf16(o[2], o[3]); w.z = cvt_pk_bf16(o[4], o[5]); w.w = cvt_pk_bf16(o[6], o[7]);
                *(GAS u32x4*)(O + (size_t)row * FF + col0) = w;
            }
        if (NAI == 2 && cp_on) {
#pragma unroll
            for (int k = 0; k < 6; ++k) if (cpd[k]) __builtin_nontemporal_store(cpv[k], cpd[k]);
        }
    }
    template <bool FINAL, int NAI, int NM>
    __device__ __forceinline__ void res(const f32x4 (&acc)[2][2][4][2], const Unit& u, int wr, int wc, int fr, int fq) const {
        GAS float* X = (GAS float*)p0; GAS bf16_t* XB = (GAS bf16_t*)p1;
        const int row0 = u.pm * 256 + wr * 64 + fr, col0 = u.pn * 256 + wc * 32 + 8 * fq;
#pragma unroll
        for (int ai = 0; ai < NAI; ++ai)
#pragma unroll
            for (int m = 0; m < NM; ++m) {
                const int row = row0 + ai * 128 + m * 16; float ss = 0.f;
#pragma unroll
                for (int bj = 0; bj < 2; ++bj) {
                    GAS bf16_t* px = XB + (size_t)row * D + col0 + bj * 128;
                    const u32x4 ob = *(const GAS u32x4*)px;
                    const f32x4 b0 = (f32x4){__uint_as_float(ob.x << 16), __uint_as_float(ob.x & 0xffff0000u), __uint_as_float(ob.y << 16), __uint_as_float(ob.y & 0xffff0000u)};
                    const f32x4 b1 = (f32x4){__uint_as_float(ob.z << 16), __uint_as_float(ob.z & 0xffff0000u), __uint_as_float(ob.w << 16), __uint_as_float(ob.w & 0xffff0000u)};
                    const f32x4 v0 = b0 + acc[ai][bj][m][0] * alpha, v1 = b1 + acc[ai][bj][m][1] * alpha;
                    ss += (v0[0] * v0[0] + v0[1] * v0[1]) + (v0[2] * v0[2] + v0[3] * v0[3]) + (v1[0] * v1[0] + v1[1] * v1[1]) + (v1[2] * v1[2] + v1[3] * v1[3]);
                    if (FINAL) { GAS float* pf = X + (size_t)row * D + col0 + bj * 128; *(GAS f32x4*)pf = v0; *(GAS f32x4*)(pf + 4) = v1; }
                    else { u32x4 w; w.x = cvt_pk_bf16(v0[0], v0[1]); w.y = cvt_pk_bf16(v0[2], v0[3]); w.z = cvt_pk_bf16(v1[0], v1[1]); w.w = cvt_pk_bf16(v1[2], v1[3]); *(GAS u32x4*)px = w; }
                }
                ss += __shfl_xor(ss, 16); ss += __shfl_xor(ss, 32);
                if (fq == 0) ssq[(size_t)row * 16 + u.pn * 4 + wc] = ss;
            }
    }
    template <int NAI, int NM>
    __device__ __forceinline__ void store(const f32x4 (&acc)[2][2][4][2], const Unit& u, int wr, int wc, int fr, int fq) const {
        GAS bf16_t* O = (GAS bf16_t*)p0;
        const int row0 = u.pm * 256 + wr * 64 + fr, col0 = u.pn * 256 + wc * 32 + 8 * fq;
#pragma unroll
        for (int ai = 0; ai < NAI; ++ai)
#pragma unroll
            for (int m = 0; m < NM; ++m) {
                const int row = row0 + ai * 128 + m * 16;
#pragma unroll
                for (int bj = 0; bj < 2; ++bj) {
                    const f32x4 v0 = acc[ai][bj][m][0], v1 = acc[ai][bj][m][1];
                    u32x4 w; w.x = cvt_pk_bf16(v0[0], v0[1]); w.y = cvt_pk_bf16(v0[2], v0[3]); w.z = cvt_pk_bf16(v1[0], v1[1]); w.w = cvt_pk_bf16(v1[2], v1[3]);
                    *(GAS u32x4*)(O + (size_t)row * D + col0 + bj * 128) = w;
                }
            }
    }
    template <bool ISQ, int NAI, int NM>
    __device__ __forceinline__ void kvq(const f32x4 (&acc)[2][2][4][2], const Unit& u, int wr, int wc, int fr, int fq) const {
        const int row0 = u.pm * 256 + wr * 64 + fr;
        const bool isK = ISQ || u.pn < 4;
        const int colb = (ISQ ? u.pn : (u.pn & 3)) * 256 + wc * 32 + 4 * fq;
        GAS bf16_t* dstb = (GAS bf16_t*)((ISQ || isK) ? p0 : p1);
        const int ldo = ISQ ? NQ : D;
        const bool dorope = isK && wc == 0;
#pragma unroll
        for (int ai = 0; ai < NAI; ++ai)
#pragma unroll
            for (int m = 0; m < NM; ++m) {
                const int row = row0 + ai * 128 + m * 16; const float r = row_rs(ssq, row, fq) * (ISQ ? QSCALE : 1.0f);
                const bool prompt = row < MP;
                const int t = row & (SEQ - 1), b = row >> 13, sb = row - MP;
                const int pidx = prompt ? t : SEQ;
                GAS float* fdst = nullptr;
                if (!ISQ) {
                    if (prompt) { if (t >= SEQ - WMAX) fdst = out + (isK ? O_CKP : O_CVP) + ((size_t)b * WMAX + (t - (SEQ - WMAX))) * D; }
                    else if (sb < NS) fdst = out + (isK ? O_CKS : O_CVS) + ((size_t)sb * WMAX + (WMAX - 1)) * D;
                }
                f32x4 cs = (f32x4){1.f, 1.f, 1.f, 1.f}, sn = (f32x4){0.f, 0.f, 0.f, 0.f};
                if (dorope) { cs = *(const GAS f32x4*)(rope + (size_t)pidx * 32 + 4 * fq); sn = *(const GAS f32x4*)(rope + (size_t)pidx * 32 + 16 + 4 * fq); }
#pragma unroll
                for (int bj = 0; bj < 2; ++bj) {
                    f32x4 v0 = acc[ai][bj][m][0] * r, v1 = acc[ai][bj][m][1] * r;
                    if (dorope) { const f32x4 r1 = v0 * cs - v1 * sn, r2 = v1 * cs + v0 * sn; v0 = r1; v1 = r2; }
                    const int c = colb + bj * 128;
                    u32x2 w0, w1; w0.x = cvt_pk_bf16(v0[0], v0[1]); w0.y = cvt_pk_bf16(v0[2], v0[3]); w1.x = cvt_pk_bf16(v1[0], v1[1]); w1.y = cvt_pk_bf16(v1[2], v1[3]);
                    *(GAS u32x2*)(dstb + (size_t)row * ldo + c) = w0; *(GAS u32x2*)(dstb + (size_t)row * ldo + c + 16) = w1;
                    if (!ISQ) { if (fdst) { *(GAS f32x4*)(fdst + c) = v0; *(GAS f32x4*)(fdst + c + 16) = v1; } }
                }
            }
    }
    template <int NAI, int NM>
    __device__ __forceinline__ void run(const f32x4 (&acc)[2][2][4][2], const Unit& u, int wr, int wc, int fr, int fq) const {
        if (kind == 0) swiglu<NAI, NM>(acc, u, wr, wc, fr, fq);
        else if (kind == 1) res<false, NAI, NM>(acc, u, wr, wc, fr, fq);
        else if (kind == 5) res<true, NAI, NM>(acc, u, wr, wc, fr, fq);
        else if (kind == 2) store<NAI, NM>(acc, u, wr, wc, fr, fq);
        else if (kind == 3) kvq<false, NAI, NM>(acc, u, wr, wc, fr, fq);
        else kvq<true, NAI, NM>(acc, u, wr, wc, fr, fq);
    }
    __device__ __forceinline__ void operator()(const f32x4 (&acc)[2][2][4][2], const Unit& u, int wr, int wc, int fr, int fq) const { run<2, 4>(acc, u, wr, wc, fr, fq); }
};

__device__ __forceinline__ void skinny_item(LAS unsigned char* lds, const pg8::Gemm g, const EpiAll& E, int item) {
    int t_ = threadIdx.x; asm volatile("" : "+v"(t_));
    const int tid = t_, lane = tid & 63, wave = __builtin_amdgcn_readfirstlane(tid >> 6), fr = lane & 15, fq = lane >> 4;
    const int pn = item >> 2, wc = item & 3, K = g.K, ksp = K >> 3, steps = ksp >> 5;
    const bool perm = E.perm();
    const GAS bf16_t* ap[2]; const GAS bf16_t* bp[2][2];
#pragma unroll
    for (int m = 0; m < 2; ++m) ap[m] = g.A + (size_t)(MP + 16 * m + fr) * g.lda + (size_t)pn * g.acol + wave * ksp + 8 * fq;
#pragma unroll
    for (int bj = 0; bj < 2; ++bj)
#pragma unroll
        for (int n = 0; n < 2; ++n) { const int rloc = perm ? (8 * (fr >> 2) + 4 * n + (fr & 3)) : (16 * n + fr);
            bp[bj][n] = g.Bt + (size_t)(256 * pn + 128 * bj + 32 * wc + rloc) * K + wave * ksp + 8 * fq; }
    f32x4 acc[2][2][4][2];
#pragma unroll
    for (int bj = 0; bj < 2; ++bj)
#pragma unroll
        for (int m = 0; m < 2; ++m)
#pragma unroll
            for (int n = 0; n < 2; ++n) acc[0][bj][m][n] = (f32x4){0.f, 0.f, 0.f, 0.f};
#pragma unroll 4
    for (int s = 0; s < steps; ++s) {
        bf16x8 a[2], b[2][2];
#pragma unroll
        for (int m = 0; m < 2; ++m) a[m] = *(const GAS bf16x8*)(ap[m] + 32 * s);
#pragma unroll
        for (int bj = 0; bj < 2; ++bj)
#pragma unroll
            for (int n = 0; n < 2; ++n) b[bj][n] = *(const GAS bf16x8*)(bp[bj][n] + 32 * s);
#pragma unroll
        for (int bj = 0; bj < 2; ++bj)
#pragma unroll
            for (int m = 0; m < 2; ++m)
#pragma unroll
                for (int n = 0; n < 2; ++n) acc[0][bj][m][n] = __builtin_amdgcn_mfma_f32_16x16x32_bf16(b[bj][n], a[m], acc[0][bj][m][n], 0, 0, 0);
    }
    LAS f32x4* red = (LAS f32x4*)lds;
#pragma unroll
    for (int bj = 0; bj < 2; ++bj)
#pragma unroll
        for (int m = 0; m < 2; ++m)
#pragma unroll
            for (int n = 0; n < 2; ++n) red[(wave * 8 + (bj * 4 + m * 2 + n)) * 64 + lane] = acc[0][bj][m][n];
    __syncthreads();
    if (wave == 0) {
#pragma unroll
        for (int bj = 0; bj < 2; ++bj)
#pragma unroll
            for (int m = 0; m < 2; ++m)
#pragma unroll
                for (int n = 0; n < 2; ++n) { f32x4 s = red[(bj * 4 + m * 2 + n) * 64 + lane];
#pragma unroll
                    for (int w = 1; w < 8; ++w) s += red[(w * 8 + (bj * 4 + m * 2 + n)) * 64 + lane];
                    acc[0][bj][m][n] = s; }
        Unit u; u.pm = MP / 256; u.pn = pn; u.ui = 0;
        E.run<1, 2>(acc, u, 0, wc, fr, fq);
    }
    __syncthreads();
}
__device__ __forceinline__ void transpose_item(const float* W, int K, int N, bf16_t* WT, int dst_row0, int k0, int n0, LAS float* scr, int lane, const float* kgain, const float* ngain) {
    { f32x4 v[8];
#pragma unroll
      for (int i = 0; i < 8; ++i) { const int kk = 8 * i + (lane >> 3); v[i] = *(const GAS f32x4*)(W + (size_t)(k0 + kk) * N + n0 + 4 * (lane & 7)); }
#pragma unroll
      for (int i = 0; i < 8; ++i) { const int kk = 8 * i + (lane >> 3); const float kg = kgain ? kgain[k0 + kk] : 1.0f; LAS float* d = scr + kk * 33 + 4 * (lane & 7);
          d[0] = v[i][0] * kg; d[1] = v[i][1] * kg; d[2] = v[i][2] * kg; d[3] = v[i][3] * kg; } }
    asm volatile("s_waitcnt lgkmcnt(0)" ::: "memory");
    const int c = lane & 7;
#pragma unroll
    for (int j = 0; j < 4; ++j) { const int n = (lane >> 3) + 8 * j; const LAS float* s = scr + (8 * c) * 33 + n; const float ng = ngain ? ngain[n0 + n] : 1.0f;
        u32x4 o; o.x = cvt_pk_bf16(s[0 * 33] * ng, s[1 * 33] * ng); o.y = cvt_pk_bf16(s[2 * 33] * ng, s[3 * 33] * ng); o.z = cvt_pk_bf16(s[4 * 33] * ng, s[5 * 33] * ng); o.w = cvt_pk_bf16(s[6 * 33] * ng, s[7 * 33] * ng);
        *(GAS u32x4*)(WT + (size_t)(dst_row0 + n) * K + k0 + 8 * c) = o; }
    asm volatile("s_waitcnt lgkmcnt(0)" ::: "memory");
}
__device__ __forceinline__ void transpose_matrix(const float* W, int K, int N, bf16_t* WT, int mode, const float* kgain, const float* ngain, LAS float* scr, int gw, int NGW, int lane) {
    const int nblk = N / 32, items = (K / 64) * nblk;
    for (int it = gw; it < items; it += NGW) {
        const int kb = it / nblk, nb = it % nblk, k0 = 64 * kb, n0 = 32 * nb;
        int dr = n0;
        if (mode == 1) { if (n0 < FF) dr = 256 * (n0 / 128) + (n0 % 128); else { const int f = n0 - FF; dr = 256 * (f / 128) + 128 + (f % 128); } }
        transpose_item(W, K, N, WT, dr, k0, n0, scr, lane, kgain, ngain);
    }
}
__device__ __forceinline__ void sincos_d(double x, double& s, double& c) {
    const double kq = rint(x * 0.63661977236758134308);
    double r = fma(-kq, 1.57079632679489655800e+00, x); r = fma(-kq, 6.12323399573676603587e-17, r);
    const double r2 = r * r;
    const double sp = r * (1.0 + r2 * (-1.0 / 6 + r2 * (1.0 / 120 + r2 * (-1.0 / 5040 + r2 * (1.0 / 362880 + r2 * (-1.0 / 39916800 + r2 * (1.0 / 6227020800.0 + r2 * (-1.0 / 1307674368000.0))))))));
    const double cp = 1.0 + r2 * (-0.5 + r2 * (1.0 / 24 + r2 * (-1.0 / 720 + r2 * (1.0 / 40320 + r2 * (-1.0 / 3628800 + r2 * (1.0 / 479001600.0 + r2 * (-1.0 / 87178291200.0 + r2 * (1.0 / 20922789888000.0))))))));
    const int q = (int)((long long)kq & 3);
    s = (q == 0) ? sp : (q == 1) ? cp : (q == 2) ? -sp : -cp;
    c = (q == 0) ? cp : (q == 1) ? -sp : (q == 2) ? -cp : sp;
}

__device__ __forceinline__ int kv_off(int row, int ch) { return 256 * row + 16 * (ch ^ (((row & 3) << 2) | ((row >> 2) & 3))); }

#define XB_TMO      128
#define XB_XCNT(j)  (256  + 64 * (j))
#define XB_XSUB(j)  (1280 + 64 * (j))
#define XB_XGEN(j)  (2304 + 64 * (j))
#define XB_TOP      3328
#define XB_TOPGEN   3392
#define XCD_BAR_WORDS 3456
#define XB_SPIN_CAP (1u << 18)

__device__ __forceinline__ unsigned xb_ld(unsigned* p)              { return __hip_atomic_load(p, __ATOMIC_RELAXED, __HIP_MEMORY_SCOPE_AGENT); }
__device__ __forceinline__ unsigned xb_add(unsigned* p, unsigned v) { return __hip_atomic_fetch_add(p, v, __ATOMIC_RELAXED, __HIP_MEMORY_SCOPE_AGENT); }
__device__ __forceinline__ unsigned xb_xcc_id() { return (unsigned)__builtin_amdgcn_s_getreg((3 << 11) | 20) & 0xFu; }
#define XB_SPIN(cond, bar) do { unsigned _sp = 0; while (cond) { __builtin_amdgcn_s_sleep(1); \
    if ((++_sp & 255u) == 0u) { if (xb_ld(&(bar)[XB_TMO])) break; if (_sp > XB_SPIN_CAP) { atomicAdd(&(bar)[XB_TMO], 1u); break; } } } } while (0)

struct XcdBarrier {
    unsigned* bar; unsigned x;
    volatile LAS unsigned* st;
};

__device__ __forceinline__ XcdBarrier xcd_barrier_post(unsigned* bar, volatile LAS unsigned* st) {
    XcdBarrier b; b.bar = bar; b.x = xb_xcc_id(); b.st = st;
    if (threadIdx.x == 0) (void)xb_add(&bar[XB_XCNT(b.x)], 1u);
    return b;
}
__device__ __forceinline__ void xcd_barrier_complete(unsigned* bar, unsigned x, unsigned& nloc, unsigned& nx) {
    const unsigned G = gridDim.x * gridDim.y * gridDim.z;
    unsigned sum, cnt, mine, sp = 0u;
    for (;;) {
        sum = 0u; cnt = 0u; mine = 0u;
#pragma unroll
        for (unsigned j = 0; j < 16; ++j) { const unsigned c = xb_ld(&bar[XB_XCNT(j)]); sum += c; cnt += (c > 0u) ? 1u : 0u; mine = (j == x) ? c : mine; }
        if (sum == G) break;
        __builtin_amdgcn_s_sleep(1);
        if ((++sp & 255u) == 0u) { if (xb_ld(&bar[XB_TMO])) break; if (sp > XB_SPIN_CAP) { atomicAdd(&bar[XB_TMO], 1u); break; } }
    }
    nloc = mine > 0u ? mine : 1u; nx = cnt > 0u ? cnt : 1u;
}

__device__ __forceinline__ void xcd_barrier(const XcdBarrier& b) {
    asm volatile("s_waitcnt vmcnt(0)" ::: "memory");
    __syncthreads();
    if (threadIdx.x == 0) {
        unsigned* bar = b.bar;
        __builtin_amdgcn_s_waitcnt(0);
        unsigned nloc = b.st[0], nx = b.st[1];
        if (nloc == 0u) { xcd_barrier_complete(bar, b.x, nloc, nx); b.st[0] = nloc; b.st[1] = nx; }
        const unsigned old = xb_add(&bar[XB_XSUB(b.x)], 1u);
        const unsigned gen = old / nloc;
        if (old + 1u == (gen + 1u) * nloc) {
            __builtin_amdgcn_fence(__ATOMIC_RELEASE, "agent");
            asm volatile("s_waitcnt vmcnt(0)" ::: "memory");
            const unsigned og = xb_add(&bar[XB_TOP], 1u);
            const unsigned tg = og / nx;
            if (og + 1u == (tg + 1u) * nx) xb_add(&bar[XB_TOPGEN], 1u);
            else XB_SPIN(xb_ld(&bar[XB_TOPGEN]) == tg, bar);
            __builtin_amdgcn_fence(__ATOMIC_ACQUIRE, "agent");
            xb_add(&bar[XB_XGEN(b.x)], 1u);
            asm volatile("s_waitcnt vmcnt(0)" ::: "memory");
        } else {
            XB_SPIN(xb_ld(&bar[XB_XGEN(b.x)]) == gen, bar);
            __builtin_amdgcn_fence(__ATOMIC_ACQUIRE, "agent");
            asm volatile("s_waitcnt vmcnt(0)" ::: "memory");
        }
    }
    __syncthreads();
}

constexpr int TAB_OFF = 131072;
struct GD { unsigned long long A, Bt, p0, p1; int N, K, lda, acol, kind, sync; float alpha; int pad; };
constexpr int NGEMM = 13;
__device__ __forceinline__ GAS unsigned char* ldp(LAS unsigned char* lds, int i) {
    const LAS unsigned* t = (const LAS unsigned*)(lds + TAB_OFF) + 2 * i;
    const unsigned lo = __builtin_amdgcn_readfirstlane(t[0]), hi = __builtin_amdgcn_readfirstlane(t[1]);
    return (GAS unsigned char*)(((unsigned long long)hi << 32) | lo);
}

#define XBAR_ST_OFF (TAB_OFF + 2048)
#define GRID_BAR() do { XcdBarrier b_; b_.bar = (unsigned*)ldp(lds, 21); b_.x = xb_xcc_id(); b_.st = (volatile LAS unsigned*)(lds + XBAR_ST_OFF); xcd_barrier(b_); } while (0)
__global__ void __launch_bounds__(512, 2) yoco_fwd(Params P) {
    extern __shared__ __attribute__((aligned(16))) unsigned char lds_raw[];
    LAS unsigned char* lds = (LAS unsigned char*)lds_raw;
    cg::grid_group grid = cg::this_grid();
    const int tid = threadIdx.x, lane = tid & 63, wave = __builtin_amdgcn_readfirstlane(tid >> 6);
    const int G = gridDim.x, bx = blockIdx.x;
    const size_t WIN_E = (size_t)2 * FF * D, WOUT_E = (size_t)D * FF;

    if (tid == 0) { ((volatile LAS unsigned*)(lds + XBAR_ST_OFF))[0] = 0u; ((volatile LAS unsigned*)(lds + XBAR_ST_OFF))[1] = 0u; }
    (void)xcd_barrier_post((unsigned*)P.ws, (volatile LAS unsigned*)(lds + XBAR_ST_OFF));
    if (tid == 0) {
        LAS unsigned long long* pt = (LAS unsigned long long*)(lds + TAB_OFF);
#define PT(i) pt[i] = (unsigned long long)P.in[i]
        PT(0); PT(1); PT(2); PT(3); PT(4); PT(5); PT(6); PT(7); PT(8); PT(9); PT(10); PT(11); PT(12); PT(13); PT(14); PT(15); PT(16); PT(17); PT(18); PT(19);
#undef PT
        pt[20] = (unsigned long long)P.out; pt[21] = (unsigned long long)P.ws;
        const unsigned long long w = (unsigned long long)P.ws;
        LAS GD* gd = (LAS GD*)(lds + TAB_OFF + 256);
        const unsigned long long XBp = w + WS_XB, ACTp = w + WS_ACT, XFp = w + WS_XF, PBp = w + WS_PB, ZBp = w + WS_ZB;
#define SETG(i, A_, B_, P0_, P1_, N_, K_, LDA_, AC_, KIND_, SYNC_, AL_) do { LAS unsigned long long* q_ = (LAS unsigned long long*)(gd + (i)); q_[0] = (A_); q_[1] = (B_); q_[2] = (P0_); q_[3] = (P1_); LAS int* r_ = (LAS int*)(q_ + 4); r_[0] = (N_); r_[1] = (K_); r_[2] = (LDA_); r_[3] = (AC_); r_[4] = (KIND_); r_[5] = (SYNC_); ((LAS float*)r_)[6] = (AL_); r_[7] = 0; } while (0)
        SETG(0, XBp, w + WS_WIN, ACTp, 0ull, 2 * FF, D, D, 0, 0, 1, 0.f);
        SETG(1, ACTp, w + WS_WOUT, XFp, XBp, D, FF, FF, 0, 1, 1, 0.5f);
        SETG(2, PBp, w + WS_WPG, ZBp, 0ull, D, 256, D, 256, 2, 1, 0.f);
        SETG(3, ZBp, w + WS_WPO, XFp, XBp, D, D, D, 0, 1, 1, 1.0f);
        SETG(4, XBp, w + WS_WIN + WIN_BYTES, ACTp, 0ull, 2 * FF, D, D, 0, 0, 1, 1.f);
        SETG(5, ACTp, w + WS_WOUT + WOUT_BYTES, XFp, XBp, D, FF, FF, 0, 1, 1, 0.5f);
        SETG(6, XBp, w + WS_WKV, w + WS_KB, w + WS_VB, 2 * D, D, D, 0, 3, 0, 0.f);
        SETG(7, XBp, w + WS_WIN + 2 * WIN_BYTES, ACTp, 0ull, 2 * FF, D, D, 0, 0, 1, 2.f);
        SETG(8, ACTp, w + WS_WOUT + 2 * WOUT_BYTES, XFp, XBp, D, FF, FF, 0, 1, 1, 0.5f);
        SETG(9, XBp, w + WS_WQ, w + WS_QB, 0ull, NQ, D, D, 0, 4, 1, 0.f);
        SETG(10, PBp, w + WS_WO, XFp, XBp, D, D, D, 0, 1, 1, 1.0f);
        SETG(11, XBp, w + WS_WIN + 3 * WIN_BYTES, ACTp, 0ull, 2 * FF, D, D, 0, 0, 1, 3.f);
        SETG(12, ACTp, w + WS_WOUT + 3 * WOUT_BYTES, XFp, XBp, D, FF, FF, 0, 1, 1, 0.5f);
#undef SETG
    }
    __syncthreads();

    {
        const int gw = bx * 8 + wave, NGW = G * 8;
        const size_t gtid = (size_t)bx * 512 + tid, GT = (size_t)G * 512;
        GAS unsigned char* ws = (GAS unsigned char*)P.ws;
        GAS bf16_t* Win = (GAS bf16_t*)(ws + WS_WIN); GAS bf16_t* Wout = (GAS bf16_t*)(ws + WS_WOUT); GAS bf16_t* Wpg = (GAS bf16_t*)(ws + WS_WPG);
        LAS float* scr = (LAS float*)(lds + wave * 16384);
        transpose_matrix(P.in[6], D, 2 * FF, Win, 1, P.in[5], nullptr, scr, gw, NGW, lane);
        transpose_matrix(P.in[10], D, 2 * FF, Win + WIN_E, 1, P.in[9], nullptr, scr, gw, NGW, lane);
        transpose_matrix(P.in[6] + WIN_E, D, 2 * FF, Win + 2 * WIN_E, 1, P.in[5] + D, nullptr, scr, gw, NGW, lane);
        transpose_matrix(P.in[10] + WIN_E, D, 2 * FF, Win + 3 * WIN_E, 1, P.in[9] + D, nullptr, scr, gw, NGW, lane);
        transpose_matrix(P.in[7], FF, D, Wout, 0, nullptr, nullptr, scr, gw, NGW, lane);
        transpose_matrix(P.in[11], FF, D, Wout + WOUT_E, 0, nullptr, nullptr, scr, gw, NGW, lane);
        transpose_matrix(P.in[7] + WOUT_E, FF, D, Wout + 2 * WOUT_E, 0, nullptr, nullptr, scr, gw, NGW, lane);
        transpose_matrix(P.in[11] + WOUT_E, FF, D, Wout + 3 * WOUT_E, 0, nullptr, nullptr, scr, gw, NGW, lane);
        for (int gi = 0; gi < 4; ++gi) transpose_matrix(P.in[12] + (size_t)gi * 65536, 256, 256, Wpg + (size_t)gi * 65536, 0, nullptr, P.in[13] + gi * 256, scr, gw, NGW, lane);
        transpose_matrix(P.in[14], D, D, (GAS bf16_t*)(ws + WS_WPO), 0, nullptr, nullptr, scr, gw, NGW, lane);
        transpose_matrix(P.in[16], D, 2 * D, (GAS bf16_t*)(ws + WS_WKV), 0, P.in[15], nullptr, scr, gw, NGW, lane);
        transpose_matrix(P.in[17], D, NQ, (GAS bf16_t*)(ws + WS_WQ), 0, P.in[8] + D, nullptr, scr, gw, NGW, lane);
        transpose_matrix(P.in[18], D, D, (GAS bf16_t*)(ws + WS_WO), 0, nullptr, nullptr, scr, gw, NGW, lane);
        {
            const GAS float* x_prompt = (const GAS float*)P.in[0]; const GAS float* x_sample = (const GAS float*)P.in[1];
            GAS bf16_t* XB = (GAS bf16_t*)(ws + WS_XB); GAS float* ssq = (GAS float*)(ws + WS_SSQ);
            for (int row0 = gw; row0 < MV; row0 += 4 * NGW) {
                f32x4 v[4][4];
#pragma unroll
                for (int q = 0; q < 4; ++q) { const int row = row0 + q * NGW; const int rc = row < MV ? row : MV - 1;
                    const GAS f32x4* xr = (const GAS f32x4*)(rc < MP ? x_prompt + (size_t)rc * D : x_sample + (size_t)(rc - MP) * D) + lane;
#pragma unroll
                    for (int j = 0; j < 4; ++j) v[q][j] = xr[64 * j]; }
#pragma unroll
                for (int q = 0; q < 4; ++q) { const int row = row0 + q * NGW;
                    float s = 0.f;
#pragma unroll
                    for (int j = 0; j < 4; ++j) s += (v[q][j][0] * v[q][j][0] + v[q][j][1] * v[q][j][1]) + (v[q][j][2] * v[q][j][2] + v[q][j][3] * v[q][j][3]);
                    s = wave_sum(s);
                    if (row < MV) {
                        GAS u32x2* bo = (GAS u32x2*)(XB + (size_t)row * D) + lane;
#pragma unroll
                        for (int j = 0; j < 4; ++j) { u32x2 w; w.x = cvt_pk_bf16(v[q][j][0], v[q][j][1]); w.y = cvt_pk_bf16(v[q][j][2], v[q][j][3]); bo[64 * j] = w; }
                        if (lane < 16) ssq[(size_t)row * 16 + lane] = lane == 0 ? s : 0.f;
                    }
                }
            }
        }
        {
            GAS float* rope = (GAS float*)(ws + WS_ROPE);
            for (size_t i = gtid; i < (size_t)(SEQ + 1) * 16; i += GT) {
                const int pi = (int)(i >> 4), fi = (int)(i & 15); const double pos = pi < SEQ ? (double)pi : 16384.0;
                double iv = P.invf[0];
#define IV(k) if (fi == k) iv = P.invf[k]
                IV(1); IV(2); IV(3); IV(4); IV(5); IV(6); IV(7); IV(8); IV(9); IV(10); IV(11); IV(12); IV(13); IV(14); IV(15);
#undef IV
                double s, c; sincos_d(pos * iv, s, c);
                rope[(size_t)pi * 32 + fi] = (float)c; rope[(size_t)pi * 32 + 16 + fi] = (float)s;
            }
        }
    }
    if (G == 0x7fffffff) grid.sync();
    GRID_BAR();

    for (int gi = 0; gi < NGEMM; ++gi) {
        if (gi == 2) {
            int t_ = threadIdx.x; asm volatile("" : "+v"(t_)); const int tid = t_, lane = tid & 63, wave = __builtin_amdgcn_readfirstlane(tid >> 6); (void)lane; (void)wave;
            GAS unsigned char* ws = ldp(lds, 21); GAS float* out = (GAS float*)ldp(lds, 20);
            const GAS float* mix_norm = (const GAS float*)ldp(lds, 8); const GAS float* state_pool = (const GAS float*)ldp(lds, 2);
            const GAS float* ssq = (const GAS float*)(ws + WS_SSQ); const GAS bf16_t* XB = (const GAS bf16_t*)(ws + WS_XB); GAS bf16_t* PBUF = (GAS bf16_t*)(ws + WS_PB);
#define LDH(r_) ({ const u32x2 q_ = *(const GAS u32x2*)(XB + (size_t)(r_) * D + 4 * cq); (f32x4){__uint_as_float(q_.x << 16), __uint_as_float(q_.x & 0xffff0000u), __uint_as_float(q_.y << 16), __uint_as_float(q_.y & 0xffff0000u)}; })
            LAS float* rr = (LAS float*)lds;
            for (int unit = bx; unit < MP / 64 + NS; unit += G) {
                __syncthreads();
                if (unit < MP / 64) {
                    const int R0 = unit * 64, b = R0 >> 13, t0 = R0 & (SEQ - 1);
                    if (tid < 80) { const int tt = tid - 16; float r = 0.f;
                        if (t0 + tt >= 0) { const GAS float* sp = ssq + (size_t)(R0 + tt) * 16; float s = 0.f;
#pragma unroll
                            for (int j = 0; j < 16; ++j) s += sp[j];
                            r = rsqrtf(s * (1.0f / D) + RMS_EPS); }
                        rr[tid] = r; }
                    __syncthreads();
                    const int cq = tid & 255, half = tid >> 8, gq = cq >> 6, w = 2 << gq;
                    const f32x4 gm = *(const GAS f32x4*)(mix_norm + 4 * cq);
                    const int s0 = half * 32;
                    f32x4 win = (f32x4){0.f, 0.f, 0.f, 0.f};
#define LDRAW(r_) (*(const GAS u32x2*)(XB + (size_t)(r_) * D + 4 * cq))
#define UNP2(q_) ((f32x4){__uint_as_float((q_).x << 16), __uint_as_float((q_).x & 0xffff0000u), __uint_as_float((q_).y << 16), __uint_as_float((q_).y & 0xffff0000u)})
                    {
                        u32x2 hv[15];
#pragma unroll
                        for (int i = 1; i < 16; ++i) { const int tt = s0 - i; hv[i - 1] = (i < w && t0 + tt >= 0) ? LDRAW(R0 + tt) : (u32x2){0u, 0u}; }
#pragma unroll
                        for (int i = 1; i < 16; ++i) { const int tt = s0 - i; if (i < w && t0 + tt >= 0) win += UNP2(hv[i - 1]) * rr[tt + 16] * gm; }
                    }
                    for (int tb = s0; tb < s0 + 32; tb += 8) {
                        u32x2 cv[8], ov[8];
#pragma unroll
                        for (int k = 0; k < 8; ++k) { cv[k] = LDRAW(R0 + tb + k); const int to = tb + k - w + 1; ov[k] = (t0 + to >= 0) ? LDRAW(R0 + to) : (u32x2){0u, 0u}; }
#pragma unroll
                        for (int k = 0; k < 8; ++k) { const int tt = tb + k;
                            const f32x4 hc = UNP2(cv[k]) * rr[tt + 16] * gm;
                            win += hc;
                            const int t = t0 + tt; const float inv = 1.0f / (float)(t + 1 < w ? t + 1 : w);
                            const f32x4 p = win * inv - hc;
                            u32x2 o; o.x = cvt_pk_bf16(p[0], p[1]); o.y = cvt_pk_bf16(p[2], p[3]);
                            *(GAS u32x2*)(PBUF + (size_t)(R0 + tt) * D + 4 * cq) = o;
                            if (t >= SEQ - PB) *(GAS f32x4*)(out + O_SPP + ((size_t)b * PB + (t - (SEQ - PB))) * D + 4 * cq) = hc;
                            const int to = tt - w + 1; if (t0 + to >= 0) win -= UNP2(ov[k]) * rr[to + 16] * gm; }
                    }
#undef UNP2
#undef LDRAW
                } else {
                    const int sb = unit - MP / 64, row = MP + sb;
                    if (tid < 256) {
                        const int cq = tid, gq = cq >> 6, w = 2 << gq;
                        const GAS float* sp = ssq + (size_t)row * 16; float s = 0.f;
#pragma unroll
                        for (int j = 0; j < 16; ++j) s += sp[j];
                        const float r = rsqrtf(s * (1.0f / D) + RMS_EPS);
                        const f32x4 gm = *(const GAS f32x4*)(mix_norm + 4 * cq);
                        const f32x4 hn = LDH(row) * r * gm;
                        f32x4 win = hn;
                        for (int i = 0; i < PB; ++i) {
                            const f32x4 pv = *(const GAS f32x4*)(state_pool + ((size_t)sb * PB + i) * D + 4 * cq);
                            if (i >= PB - (w - 1)) win += pv;
                            if (i >= 1) *(GAS f32x4*)(out + O_SPS + ((size_t)sb * PB + (i - 1)) * D + 4 * cq) = pv;
                        }
                        *(GAS f32x4*)(out + O_SPS + ((size_t)sb * PB + (PB - 1)) * D + 4 * cq) = hn;
                        const f32x4 p = win * (1.0f / (float)w) - hn;
                        u32x2 o; o.x = cvt_pk_bf16(p[0], p[1]); o.y = cvt_pk_bf16(p[2], p[3]);
                        *(GAS u32x2*)(PBUF + (size_t)row * D + 4 * cq) = o;
                    }
                }
            }
            GRID_BAR();
        }
        if (gi == 10) {
            {
                int t_ = threadIdx.x; asm volatile("" : "+v"(t_)); const int tid = t_, lane = tid & 63, wave = __builtin_amdgcn_readfirstlane(tid >> 6);
                GAS unsigned char* ws = ldp(lds, 21);
                const GAS bf16_t* KB = (const GAS bf16_t*)(ws + WS_KB); const GAS bf16_t* VB = (const GAS bf16_t*)(ws + WS_VB); const GAS bf16_t* QB = (const GAS bf16_t*)(ws + WS_QB);
                GAS bf16_t* OG = (GAS bf16_t*)(ws + WS_OG); GAS float* lse = (GAS float*)(ws + WS_LSE);
                const int qi = lane & 15, qd = lane >> 4;
                const int per = (6144 + G - 1) / G, u0 = bx * per, u1 = (u0 + per < 6144) ? u0 + per : 6144;
                u32x4 kr[4], vr[4]; bf16x8 qn[4];
#define DEC(u_, gq_, b_, h_, cls_, n_, dl_) const int gq_ = (u_) / 2048, b_ = ((u_) >> 9) & 3, h_ = ((u_) >> 6) & 7, blk_##u_ = (u_) & 63; const int dl_ = gq_ == 0 ? 1 : (gq_ == 1 ? 4 : 16); const int nbk_##u_ = 64 / dl_, cls_ = blk_##u_ / nbk_##u_, n_ = blk_##u_ % nbk_##u_
#define ISSUE(gq_, b_, h_, cls_, n_, dl_) do { \
                    _Pragma("unroll") for (int i = 0; i < 4; ++i) { const int c = tid + 512 * i, row = c >> 4, ch = c & 15; \
                        const size_t so = ((size_t)(b_) * SEQ + (size_t)((128 * (n_) + row) * (dl_) + (cls_))) * D + (h_) * HD + ch * 8; kr[i] = *(const GAS u32x4*)(KB + so); vr[i] = *(const GAS u32x4*)(VB + so); } \
                    { const size_t qrow_ = (size_t)(b_) * SEQ + (size_t)((128 * (n_) + 16 * wave + qi) * (dl_) + (cls_)); \
                      _Pragma("unroll") for (int s = 0; s < 4; ++s) qn[s] = *(const GAS bf16x8*)(QB + qrow_ * NQ + ((gq_) * 8 + (h_)) * HD + 32 * s + 8 * qd); } } while (0)
                int rot = 0; bool chained = false;
                { const int uu = u0 < 6144 ? u0 : 6143; DEC(uu, g0, b0, h0, c0, n0, d0); ISSUE(g0, b0, h0, c0, n0, d0); }
                for (int u = u0; u < u1; ++u) {
                    DEC(u, gq, b, h, cls, n, dl);
                    __syncthreads();
                    {
                        const unsigned rx = (unsigned)rot << 15;
#pragma unroll
                        for (int i = 0; i < 4; ++i) { const int c = tid + 512 * i, row = c >> 4, ch = c & 15;
                            const unsigned oo = (unsigned)kv_off(128 + row, ch) ^ rx; *(LAS u32x4*)(lds + oo) = kr[i]; *(LAS u32x4*)(lds + 65536 + oo) = vr[i];
                        }
                        if (!chained) {
#pragma unroll
                            for (int i = 0; i < 4; ++i) { const int c = tid + 512 * i, row = c >> 4, ch = c & 15;
                                u32x4 kp = (u32x4){0u, 0u, 0u, 0u}, vp = (u32x4){0u, 0u, 0u, 0u};
                                if (n > 0) { const size_t sp = ((size_t)b * SEQ + (size_t)((128 * (n - 1) + row) * dl + cls)) * D + h * HD + ch * 8; kp = *(const GAS u32x4*)(KB + sp); vp = *(const GAS u32x4*)(VB + sp); }
                                const unsigned op = (unsigned)kv_off(row, ch) ^ rx; *(LAS u32x4*)(lds + op) = kp; *(LAS u32x4*)(lds + 65536 + op) = vp; }
                        }
                    }
                    bf16x8 qf[4];
#pragma unroll
                    for (int s = 0; s < 4; ++s) qf[s] = qn[s];
                    __syncthreads();
                    const int rotc = rot;
                    { const int un = (u + 1 < u1) ? u + 1 : u;
                      DEC(un, g1, b1, h1, c1, n1, d1); const bool ch1 = (n1 != 0) && ((un & 63) != 0) && (un != u);
                      ISSUE(g1, b1, h1, c1, n1, d1);
                      chained = ch1; rot = ch1 ? (rot ^ 1) : 0; }
                    const unsigned rx = (unsigned)rotc << 15;
                    const int ii = 16 * wave + qi; const size_t qrow = (size_t)b * SEQ + (size_t)((128 * n + ii) * dl + cls);
                    const int kw = 16 * wave;
                    f32x4 Sx[9];
                    {
                        bf16x8 kf[2][4];
#pragma unroll
                        for (int s = 0; s < 4; ++s) kf[0][s] = *(const LAS bf16x8*)(lds + ((unsigned)kv_off(kw + qi, 4 * s + qd) ^ rx));
#pragma unroll
                        for (int j = 0; j < 9; ++j) {
                            if (j < 8) {
#pragma unroll
                                for (int s = 0; s < 4; ++s) kf[(j + 1) & 1][s] = *(const LAS bf16x8*)(lds + ((unsigned)kv_off(kw + 16 * (j + 1) + qi, 4 * s + qd) ^ rx));
                            }
                            f32x4 a = (f32x4){0.f, 0.f, 0.f, 0.f};
#pragma unroll
                            for (int s = 0; s < 4; ++s) a = __builtin_amdgcn_mfma_f32_16x16x32_bf16(kf[j & 1][s], qf[s], a, 0, 0, 0);
                            if (j == 0) {
#pragma unroll
                                for (int e = 0; e < 4; ++e) a[e] = (4 * qd + e >= qi) ? a[e] : -INFINITY; }
                            if (j == 8) {
#pragma unroll
                                for (int e = 0; e < 4; ++e) a[e] = (4 * qd + e <= qi) ? a[e] : -INFINITY; }
                            Sx[j] = a;
                        }
                    }
                    if (n == 0) {
#pragma unroll
                        for (int j = 0; j < 8; ++j) if (wave + j < 8) Sx[j] = (f32x4){-INFINITY, -INFINITY, -INFINITY, -INFINITY};
                    }
                    float mx = -INFINITY;
#pragma unroll
                    for (int kt = 0; kt < 9; ++kt) mx = fmaxf(mx, fmaxf(fmaxf(Sx[kt][0], Sx[kt][1]), fmaxf(Sx[kt][2], Sx[kt][3])));
                    mx = fmaxf(mx, __shfl_xor(mx, 16)); mx = fmaxf(mx, __shfl_xor(mx, 32));
                    float ls = 0.f;
#pragma unroll
                    for (int kt = 0; kt < 9; ++kt)
#pragma unroll
                        for (int e = 0; e < 4; ++e) { const float p = __builtin_amdgcn_exp2f(Sx[kt][e] - mx); Sx[kt][e] = p; ls += p; }
                    ls += __shfl_xor(ls, 16); ls += __shfl_xor(ls, 32);
                    f32x4 O[8];
#pragma unroll
                    for (int dt = 0; dt < 8; ++dt) O[dt] = (f32x4){0.f, 0.f, 0.f, 0.f};
                    const int q4 = qi >> 2, p4 = qi & 3, sw = (q4 << 2) | qd;
                    const unsigned vlane = 65536u + 256u * (unsigned)(4 * qd + q4) + 8u * (unsigned)(p4 & 1);
#define TRR(dst, addr) asm volatile("ds_read_b64_tr_b16 %0, %1" : "=&v"(dst) : "v"(addr) : "memory")
#define TRBATCH(i_, L_, H_) do { const int ks_ = (i_) >> 1, dh_ = (i_) & 1; const int tl_ = 2 * ks_, th_ = (2 * ks_ + 1 < 9) ? 2 * ks_ + 1 : 8; \
                        const unsigned blo_ = ((256u * (unsigned)(kw + 16 * tl_)) ^ rx) + vlane, bhi_ = ((256u * (unsigned)(kw + 16 * th_)) ^ rx) + vlane; \
                        _Pragma("unroll") for (int d4 = 0; d4 < 4; ++d4) { const int dt_ = 4 * dh_ + d4; const unsigned co_ = 16u * (unsigned)((2 * dt_ + (p4 >> 1)) ^ sw); const unsigned a0_ = blo_ + co_, a1_ = bhi_ + co_; TRR(L_[d4], a0_); TRR(H_[d4], a1_); } } while (0)
#define PVMMA(i_, L_, H_) do { const int ks_ = (i_) >> 1, dh_ = (i_) & 1; \
                        bf16x8 pf_; { u32x4 t_; t_.x = cvt_pk_bf16(Sx[2 * ks_][0], Sx[2 * ks_][1]); t_.y = cvt_pk_bf16(Sx[2 * ks_][2], Sx[2 * ks_][3]); \
                            if (2 * ks_ + 1 < 9) { t_.z = cvt_pk_bf16(Sx[(2 * ks_ + 1 < 9) ? 2 * ks_ + 1 : 8][0], Sx[(2 * ks_ + 1 < 9) ? 2 * ks_ + 1 : 8][1]); t_.w = cvt_pk_bf16(Sx[(2 * ks_ + 1 < 9) ? 2 * ks_ + 1 : 8][2], Sx[(2 * ks_ + 1 < 9) ? 2 * ks_ + 1 : 8][3]); } else { t_.z = 0u; t_.w = 0u; } \
                            pf_ = __builtin_bit_cast(bf16x8, t_); } \
                        _Pragma("unroll") for (int d4 = 0; d4 < 4; ++d4) { const int dt_ = 4 * dh_ + d4; const bf16x8 vf_ = (bf16x8){L_[d4][0], L_[d4][1], L_[d4][2], L_[d4][3], H_[d4][0], H_[d4][1], H_[d4][2], H_[d4][3]}; \
                            O[dt_] = __builtin_amdgcn_mfma_f32_16x16x32_bf16(vf_, pf_, O[dt_], 0, 0, 0); } } while (0)
#define TRWAIT(cnt_, L_, H_) asm volatile("s_waitcnt lgkmcnt(" #cnt_ ")" : "+v"(L_[0]), "+v"(L_[1]), "+v"(L_[2]), "+v"(L_[3]), "+v"(H_[0]), "+v"(H_[1]), "+v"(H_[2]), "+v"(H_[3]) :: "memory")
                    {
                        s16x4 la[4], ha[4], lb[4], hb[4];
                        TRBATCH(0, la, ha);
                        TRBATCH(1, lb, hb); TRWAIT(8, la, ha); PVMMA(0, la, ha);
                        TRBATCH(2, la, ha); TRWAIT(8, lb, hb); PVMMA(1, lb, hb);
                        TRBATCH(3, lb, hb); TRWAIT(8, la, ha); PVMMA(2, la, ha);
                        TRBATCH(4, la, ha); TRWAIT(8, lb, hb); PVMMA(3, lb, hb);
                        TRBATCH(5, lb, hb); TRWAIT(8, la, ha); PVMMA(4, la, ha);
                        TRBATCH(6, la, ha); TRWAIT(8, lb, hb); PVMMA(5, lb, hb);
                        TRBATCH(7, lb, hb); TRWAIT(8, la, ha); PVMMA(6, la, ha);
                        TRBATCH(8, la, ha); TRWAIT(8, lb, hb); PVMMA(7, lb, hb);
                        TRBATCH(9, lb, hb); TRWAIT(8, la, ha); PVMMA(8, la, ha);
                        TRWAIT(0, lb, hb); PVMMA(9, lb, hb);
                    }
#undef TRWAIT
#undef PVMMA
#undef TRBATCH
#undef TRR
                    const float inv = 1.0f / ls;
                    GAS bf16_t* od = OG + ((size_t)gq * MT + qrow) * D + h * HD + 4 * qd;
#pragma unroll
                    for (int dt = 0; dt < 8; ++dt) { u32x2 w; w.x = cvt_pk_bf16(O[dt][0] * inv, O[dt][1] * inv); w.y = cvt_pk_bf16(O[dt][2] * inv, O[dt][3] * inv); *(GAS u32x2*)(od + 16 * dt) = w; }
                    if (qd == 0) lse[((size_t)gq * MT + qrow) * 8 + h] = mx + __builtin_amdgcn_logf(ls);
                }
#undef ISSUE
#undef DEC
            }
            {
                int t_ = threadIdx.x; asm volatile("" : "+v"(t_)); const int tid = t_, lane = tid & 63, wave = __builtin_amdgcn_readfirstlane(tid >> 6);
                GAS unsigned char* ws = ldp(lds, 21); const GAS float* out = (const GAS float*)ldp(lds, 20);
                const GAS float* cache_k = (const GAS float*)ldp(lds, 3); const GAS float* cache_v = (const GAS float*)ldp(lds, 4);
                const GAS bf16_t* QB = (const GAS bf16_t*)(ws + WS_QB); GAS bf16_t* PBUF = (GAS bf16_t*)(ws + WS_PB);
                LAS float* sc = (LAS float*)lds;
                LAS f32x4* red = (LAS f32x4*)(lds + 2048);
                for (int unit = bx; unit < NS * NH; unit += G) {
                    const int b = unit >> 3, h = unit & 7;
                    __syncthreads();
                    const int l16 = lane & 15, kq = lane >> 4;
#pragma unroll
                    for (int pass = 0; pass < 13; ++pass) {
                        const int pi = pass * 32 + wave * 4 + kq, pc = pi < 387 ? pi : 386;
                        const int gq = pc / 129, j = pc % 129, dl = gq == 0 ? 1 : (gq == 1 ? 4 : 16);
                        const GAS float* kp = (j == 0) ? out + O_CKS + ((size_t)b * WMAX + (WMAX - 1)) * D : cache_k + ((size_t)b * WMAX + (WMAX - dl * j)) * D;
                        const f32x4 k0 = *(const GAS f32x4*)(kp + h * HD + 8 * l16), k1 = *(const GAS f32x4*)(kp + h * HD + 8 * l16 + 4);
                        const u32x4 qv = *(const GAS u32x4*)(QB + (size_t)(MP + b) * NQ + (gq * 8 + h) * HD + 8 * l16);
                        float s = k0[0] * __uint_as_float(qv.x << 16) + k0[1] * __uint_as_float(qv.x & 0xffff0000u) + k0[2] * __uint_as_float(qv.y << 16) + k0[3] * __uint_as_float(qv.y & 0xffff0000u)
                                + k1[0] * __uint_as_float(qv.z << 16) + k1[1] * __uint_as_float(qv.z & 0xffff0000u) + k1[2] * __uint_as_float(qv.w << 16) + k1[3] * __uint_as_float(qv.w & 0xffff0000u);
                        s += __shfl_xor(s, 1); s += __shfl_xor(s, 2); s += __shfl_xor(s, 4); s += __shfl_xor(s, 8);
                        if (l16 == 0 && pi < 387) sc[pi] = s;
                    }
                    __syncthreads();
                    if (wave == 0) {
                        float v[7]; float mx = -INFINITY;
#pragma unroll
                        for (int i = 0; i < 7; ++i) { const int pi = lane + 64 * i; v[i] = pi < 387 ? sc[pi] : -INFINITY; mx = fmaxf(mx, v[i]); }
                        mx = wave_max(mx); float ls = 0.f;
#pragma unroll
                        for (int i = 0; i < 7; ++i) { const int pi = lane + 64 * i; const float p = __builtin_amdgcn_exp2f(v[i] - mx); ls += p; if (pi < 387) sc[pi] = p; }
                        ls = wave_sum(ls);
                        if (lane == 0) sc[500] = 1.0f / ls;
                    }
                    __syncthreads();
                    {
                        const int part = tid >> 5, d4 = (tid & 31) * 4; f32x4 acc = (f32x4){0.f, 0.f, 0.f, 0.f};
#pragma unroll 5
                        for (int it = 0; it < 25; ++it) {
                            const int pi = part + 16 * it, pc = pi < 387 ? pi : 386;
                            const int gq = pc / 129, j = pc % 129, dl = gq == 0 ? 1 : (gq == 1 ? 4 : 16);
                            const GAS float* vp = (j == 0) ? out + O_CVS + ((size_t)b * WMAX + (WMAX - 1)) * D : cache_v + ((size_t)b * WMAX + (WMAX - dl * j)) * D;
                            const float p = pi < 387 ? sc[pc] : 0.f;
                            acc += *(const GAS f32x4*)(vp + h * HD + d4) * p;
                        }
                        red[part * 32 + (tid & 31)] = acc;
                    }
                    __syncthreads();
                    if (tid < 128) { const LAS float* rf = (const LAS float*)red; float o = 0.f;
#pragma unroll
                        for (int pt = 0; pt < 16; ++pt) o += rf[pt * 128 + tid];
                        o *= sc[500];
                        PBUF[(size_t)(MP + b) * D + h * HD + tid] = (bf16_t)(cvt_pk_bf16(o, 0.f) & 0xffffu); }
                }
            }
            GRID_BAR();
            {
                int t_ = threadIdx.x; asm volatile("" : "+v"(t_)); const int tid = t_, lane = tid & 63, wave = __builtin_amdgcn_readfirstlane(tid >> 6); (void)lane; (void)wave;
                GAS unsigned char* ws = ldp(lds, 21);
                const GAS bf16_t* OG = (const GAS bf16_t*)(ws + WS_OG); const GAS float* lse = (const GAS float*)(ws + WS_LSE); GAS bf16_t* PBUF = (GAS bf16_t*)(ws + WS_PB);
                const size_t gtid = (size_t)bx * 512 + tid, GT = (size_t)G * 512;
                constexpr size_t NIT = (size_t)MP * 128;
                size_t i = gtid;
                for (; i + 3 * GT < NIT; i += 4 * GT) {
                    float l[4][3]; u32x4 og[4][3];
#pragma unroll
                    for (int q = 0; q < 4; ++q) { const size_t it = i + q * GT, row = it >> 7; const int ch = (int)(it & 127), h = ch >> 4;
#pragma unroll
                        for (int g3 = 0; g3 < 3; ++g3) { l[q][g3] = lse[((size_t)g3 * MT + row) * 8 + h]; og[q][g3] = *(const GAS u32x4*)(OG + ((size_t)g3 * MT + row) * D + ch * 8); } }
#pragma unroll
                    for (int q = 0; q < 4; ++q) { const size_t it = i + q * GT, row = it >> 7; const int ch = (int)(it & 127);
                        const float m = fmaxf(l[q][0], fmaxf(l[q][1], l[q][2]));
                        float w0 = __builtin_amdgcn_exp2f(l[q][0] - m), w1 = __builtin_amdgcn_exp2f(l[q][1] - m), w2 = __builtin_amdgcn_exp2f(l[q][2] - m);
                        const float inv = 1.0f / (w0 + w1 + w2); w0 *= inv; w1 *= inv; w2 *= inv;
                        u32x4 o;
#pragma unroll
                        for (int e = 0; e < 4; ++e) {
                            const float lo = w0 * __uint_as_float(og[q][0][e] << 16) + w1 * __uint_as_float(og[q][1][e] << 16) + w2 * __uint_as_float(og[q][2][e] << 16);
                            const float hi = w0 * __uint_as_float(og[q][0][e] & 0xffff0000u) + w1 * __uint_as_float(og[q][1][e] & 0xffff0000u) + w2 * __uint_as_float(og[q][2][e] & 0xffff0000u);
                            o[e] = cvt_pk_bf16(lo, hi);
                        }
                        *(GAS u32x4*)(PBUF + row * D + ch * 8) = o; }
                }
                for (; i < NIT; i += GT) {
                    const size_t row = i >> 7; const int ch = (int)(i & 127), h = ch >> 4;
                    const float l0 = lse[((size_t)0 * MT + row) * 8 + h], l1 = lse[((size_t)1 * MT + row) * 8 + h], l2 = lse[((size_t)2 * MT + row) * 8 + h];
                    const float m = fmaxf(l0, fmaxf(l1, l2));
                    float w0 = __builtin_amdgcn_exp2f(l0 - m), w1 = __builtin_amdgcn_exp2f(l1 - m), w2 = __builtin_amdgcn_exp2f(l2 - m);
                    const float inv = 1.0f / (w0 + w1 + w2); w0 *= inv; w1 *= inv; w2 *= inv;
                    const u32x4 a = *(const GAS u32x4*)(OG + ((size_t)0 * MT + row) * D + ch * 8), bb = *(const GAS u32x4*)(OG + ((size_t)1 * MT + row) * D + ch * 8), c = *(const GAS u32x4*)(OG + ((size_t)2 * MT + row) * D + ch * 8);
                    u32x4 o;
#pragma unroll
                    for (int e = 0; e < 4; ++e) {
                        const float lo = w0 * __uint_as_float(a[e] << 16) + w1 * __uint_as_float(bb[e] << 16) + w2 * __uint_as_float(c[e] << 16);
                        const float hi = w0 * __uint_as_float(a[e] & 0xffff0000u) + w1 * __uint_as_float(bb[e] & 0xffff0000u) + w2 * __uint_as_float(c[e] & 0xffff0000u);
                        o[e] = cvt_pk_bf16(lo, hi);
                    }
                    *(GAS u32x4*)(PBUF + row * D + ch * 8) = o;
                }
            }
            GRID_BAR();
        }
        {
            const LAS unsigned* wv = (const LAS unsigned*)(lds + TAB_OFF + 256 + gi * 64);
            unsigned v[16];
#pragma unroll
            for (int j = 0; j < 16; ++j) v[j] = __builtin_amdgcn_readfirstlane(wv[j]);
#define U64(a, b) (((unsigned long long)(b) << 32) | (a))
            pg8::Gemm g{(const GAS bf16_t*)U64(v[0], v[1]), (const GAS bf16_t*)U64(v[2], v[3]), MP, (int)v[8], (int)v[9], (int)v[10], (int)v[11]};
            GAS unsigned char* ws = ldp(lds, 21);
            EpiAll E{(int)v[12], (GAS void*)U64(v[4], v[5]), (GAS void*)U64(v[6], v[7]), (GAS float*)(ws + WS_SSQ), (const GAS float*)(ws + WS_ROPE), (GAS float*)ldp(lds, 20), __uint_as_float(v[14]), lds};
#undef U64
            { const int item = G - 1 - bx; if (item < (g.N >> 6)) skinny_item(lds, g, E, item); }
            pg8::StaticOrder S; S.init(MP, g.N, G, bx);
            pg8::gemm_phase(lds, g, S, E);
            if (v[13]) GRID_BAR();
        }
    }
    {
        int t_ = threadIdx.x; asm volatile("" : "+v"(t_)); const int tid = t_, lane = tid & 63, wave = __builtin_amdgcn_readfirstlane(tid >> 6);
        GAS unsigned char* ws = ldp(lds, 21); GAS float* out = (GAS float*)ldp(lds, 20); const GAS float* final_norm = (const GAS float*)ldp(lds, 19);
        const GAS float* ssq = (const GAS float*)(ws + WS_SSQ); const GAS bf16_t* XB = (const GAS bf16_t*)(ws + WS_XB);
        const int gw = bx * 8 + wave, NGW = G * 8;
        const GAS f32x4* gn = (const GAS f32x4*)final_norm + lane;
        if ((128 * 22) % G != 0) {
            constexpr unsigned per_b = (unsigned)(WMAX - 1) * D / 4, full_b = (unsigned)WMAX * D / 4, tot = 2u * NS * per_b;
            const GAS f32x4* sk = (const GAS f32x4*)ldp(lds, 3); const GAS f32x4* sv = (const GAS f32x4*)ldp(lds, 4);
            GAS f32x4* dk = (GAS f32x4*)(out + O_CKS); GAS f32x4* dv = (GAS f32x4*)(out + O_CVS);
            for (unsigned j = (unsigned)bx * 512u + (unsigned)tid; j < tot; j += (unsigned)G * 512u) { const unsigned ck = j / per_b, r = j - ck * per_b, b = ck >> 1;
                ((ck & 1) ? dv : dk)[(size_t)b * full_b + r] = ((ck & 1) ? sv : sk)[(size_t)b * full_b + (D / 4) + r]; }
        }
        const f32x4 g0 = gn[0], g1 = gn[64], g2 = gn[128], g3 = gn[192];
#define UNPK(q_) ((f32x4){__uint_as_float((q_).x << 16), __uint_as_float((q_).x & 0xffff0000u), __uint_as_float((q_).y << 16), __uint_as_float((q_).y & 0xffff0000u)})
        int row = gw;
        for (; row + 3 * NGW < MV; row += 4 * NGW) {
            f32x4 s4[4]; u32x2 q[4][4];
#pragma unroll
            for (int b4 = 0; b4 < 4; ++b4) { const int rw = row + b4 * NGW; s4[b4] = *(const GAS f32x4*)(ssq + (size_t)rw * 16 + 4 * (lane & 3));
                const GAS u32x2* xr = (const GAS u32x2*)(XB + (size_t)rw * D) + lane; q[b4][0] = xr[0]; q[b4][1] = xr[64]; q[b4][2] = xr[128]; q[b4][3] = xr[192]; }
#pragma unroll
            for (int b4 = 0; b4 < 4; ++b4) { const int rw = row + b4 * NGW;
                float s = (s4[b4][0] + s4[b4][1]) + (s4[b4][2] + s4[b4][3]); s += __shfl_xor(s, 1); s += __shfl_xor(s, 2);
                const float r = rsqrtf(s * (1.0f / D) + RMS_EPS);
                GAS f32x4* yo = (GAS f32x4*)(out + (size_t)rw * D) + lane;
                __builtin_nontemporal_store(UNPK(q[b4][0]) * r * g0, yo); __builtin_nontemporal_store(UNPK(q[b4][1]) * r * g1, yo + 64);
                __builtin_nontemporal_store(UNPK(q[b4][2]) * r * g2, yo + 128); __builtin_nontemporal_store(UNPK(q[b4][3]) * r * g3, yo + 192); }
        }
        for (; row < MV; row += NGW) {
            const f32x4 s4 = *(const GAS f32x4*)(ssq + (size_t)row * 16 + 4 * (lane & 3));
            float s = (s4[0] + s4[1]) + (s4[2] + s4[3]); s += __shfl_xor(s, 1); s += __shfl_xor(s, 2);
            const float r = rsqrtf(s * (1.0f / D) + RMS_EPS);
            const GAS u32x2* xr = (const GAS u32x2*)(XB + (size_t)row * D) + lane;
            GAS f32x4* yo = (GAS f32x4*)(out + (size_t)row * D) + lane;
            const u32x2 q0 = xr[0], q1 = xr[64], q2 = xr[128], q3 = xr[192];
            __builtin_nontemporal_store(UNPK(q0) * r * g0, yo); __builtin_nontemporal_store(UNPK(q1) * r * g1, yo + 64);
            __builtin_nontemporal_store(UNPK(q2) * r * g2, yo + 128); __builtin_nontemporal_store(UNPK(q3) * r * g3, yo + 192);
#undef UNPK
        }
    }
}

extern "C" void kernel_launch(void* const* d_in, const int* in_sizes, int n_in, void* d_out, int out_size, void* d_ws, size_t ws_size, hipStream_t stream) {
    static int grid = 0;
    if (grid == 0) {
        if (n_in != 20 || ws_size < WS_END) { fprintf(stderr, "kernel_launch: unexpected n_in %d / ws %zu (need %zu)\n", n_in, ws_size, (size_t)WS_END); grid = -1; return; }
        int dev = 0, cus = 0, per_cu = 0;
        hipGetDevice(&dev); hipDeviceGetAttribute(&cus, hipDeviceAttributeMultiprocessorCount, dev);
        hipFuncSetAttribute((const void*)yoco_fwd, hipFuncAttributeMaxDynamicSharedMemorySize, LDS_BYTES);
        hipOccupancyMaxActiveBlocksPerMultiprocessor(&per_cu, (const void*)yoco_fwd, 512, LDS_BYTES);
        if (per_cu < 1) { fprintf(stderr, "kernel_launch: occupancy query says %d blocks/CU\n", per_cu); per_cu = 1; }
        (void)hipGetLastError();
        grid = cus * 1;
    }
    if (grid < 0) return;
    Params p{};
    for (int i = 0; i < 20; ++i) p.in[i] = (const float*)d_in[i];
    p.out = (float*)d_out; p.ws = (unsigned char*)d_ws;
    static const double invf[16] = {1.0, 0.44036660267178046, 0.19392274474868576, 0.08539710028576561, 0.03760603093086393, 0.016560440080994446, 0.007292664737217109, 0.003211445994752591,
                                    0.001414213562373095, 0.000622772421914596, 0.0002742481756762073, 0.00012076973741146504, 5.318295896944988e-05, 2.341999896140934e-05, 1.031338537721246e-05, 4.5416704806078695e-06};
    for (int i = 0; i < 16; ++i) p.invf[i] = invf[i];
    (void)hipMemsetAsync(d_ws, 0, 16384, stream);
    void* args[] = {&p};
    hipError_t e = hipLaunchCooperativeKernel((const void*)yoco_fwd, dim3(grid), dim3(512), args, LDS_BYTES, stream);
    if (e != hipSuccess) fprintf(stderr, "cooperative launch failed: %s (grid %d)\n", hipGetErrorString(e), grid);
}
```
